# Optimizing an MI355X kernel written in HIP

```python
import math
import jax, jax.numpy as jnp
from jax import lax
import numpy as np

D_MODEL = 1024
BATCH = 32
SEQ = 2048
DEPTH = 2

ATT_HEADS = 6
ATT_HEAD_DIM = 64
ATT_WIDTH = ATT_HEADS * ATT_HEAD_DIM
IDX_HEADS = 4
IDX_DIM = 64
TOPK_MAX = 256
QBLOCK = 32
POOL_GROUPS = 4
POOL_GROUP_DIM = 64
POOL_WIDTH = POOL_GROUPS * POOL_GROUP_DIM
POOL_WINDOWS = (2, 4, 8, 16)
GLA_HEADS = 4
GLA_DK = 48
GLA_DV = 96
GLA_KEY_WIDTH = GLA_HEADS * GLA_DK
GLA_VAL_WIDTH = GLA_HEADS * GLA_DV
GLA_GATE_RANK = 16
GLA_TAU = 16.0
GLA_CHUNK = 64

MIX_WIDTH = ATT_WIDTH + POOL_WIDTH + GLA_VAL_WIDTH
EPS = 1e-6

IN_SPLITS = (
    ATT_WIDTH, ATT_WIDTH, ATT_WIDTH, ATT_WIDTH,
    IDX_HEADS * IDX_DIM, IDX_DIM, IDX_HEADS,
    POOL_WIDTH, POOL_WIDTH,
    GLA_KEY_WIDTH, GLA_KEY_WIDTH, GLA_VAL_WIDTH,
    GLA_GATE_RANK, GLA_VAL_WIDTH,
)
IN_WIDTH = sum(IN_SPLITS)

kernel_name = "hybrid_dsa_pool_gla_parallel"


def rms_norm(x, gain):
    xf = x.astype(jnp.float32)
    y = xf * lax.rsqrt(jnp.mean(xf * xf, axis=-1, keepdims=True) + EPS)
    return (y * gain.astype(jnp.float32)).astype(x.dtype)


def split_columns(p):
    offs = np.cumsum(IN_SPLITS)[:-1].tolist()
    return jnp.split(p, offs, axis=-1)


def sparse_attention(q, k, v, iq, ik, iw):
    B, S, H, D = q.shape
    topk = min(TOPK_MAX, S // 4)
    nb = S // QBLOCK

    def to_blocks(a):
        return jnp.swapaxes(a.reshape((B, nb, QBLOCK) + a.shape[2:]), 0, 1)

    ikf = ik.astype(jnp.float32)
    key_pos = jnp.arange(S)

    def one_block(args):
        qb, iqb, iwb, n = args
        tpos = n * QBLOCK + jnp.arange(QBLOCK)
        s = jax.nn.relu(jnp.einsum('bqhd,bsd->bqhs', iqb.astype(jnp.float32), ikf))
        score = jnp.einsum('bqhs,bqh->bqs', s, iwb.astype(jnp.float32))
        causal = key_pos[None, :] <= tpos[:, None]
        score = jnp.where(causal[None], score, -jnp.inf)
        _, idx = lax.top_k(score, topk)
        kg = jax.vmap(lambda kk, ii: kk[ii])(k, idx)
        vg = jax.vmap(lambda vv, ii: vv[ii])(v, idx)
        logits = jnp.einsum('bqhd,bqkhd->bhqk', qb, kg).astype(jnp.float32)
        valid = idx <= tpos[None, :, None]
        logits = jnp.where(valid[:, None], logits, -jnp.inf)
        p = jax.nn.softmax(logits, axis=-1)
        return jnp.einsum('bhqk,bqkhd->bqhd', p.astype(v.dtype), vg)

    out = lax.map(one_block, (to_blocks(q), to_blocks(iq), to_blocks(iw),
                              jnp.arange(nb, dtype=jnp.int32)))
    return jnp.swapaxes(out, 0, 1).reshape(B, S, H, D)


def pool_mixer(u, w_pool, scale):
    B, S, _ = u.shape
    ug = u.astype(jnp.float32).reshape(B, S, POOL_GROUPS, POOL_GROUP_DIM)
    c = jnp.concatenate([jnp.zeros((B, 1, POOL_GROUPS, POOL_GROUP_DIM), jnp.float32),
                         jnp.cumsum(ug, axis=1)], axis=1)
    t = jnp.arange(S)
    pooled = []
    for g, w in enumerate(POOL_WINDOWS):
        start = jnp.maximum(t + 1 - w, 0)
        count = jnp.minimum(t + 1, w).astype(jnp.float32)
        mean = (c[:, t + 1, g] - c[:, start, g]) / count[None, :, None]
        pooled.append(mean - ug[:, :, g])
    pooled = jnp.stack(pooled, axis=2)
    y = jnp.einsum('bsgc,gcd->bsgd', pooled, w_pool.astype(jnp.float32))
    y = y * scale.astype(jnp.float32).reshape(POOL_GROUPS, POOL_GROUP_DIM)
    return y.reshape(B, S, POOL_WIDTH).astype(u.dtype)


def gla_chunked(q, k, v, glog):
    B, S, H, DK = q.shape
    DV = v.shape[-1]
    C = GLA_CHUNK
    N = S // C

    def to_chunks(a):
        return a.astype(jnp.float32).reshape(B, N, C, H, a.shape[-1]).transpose(1, 0, 3, 2, 4)

    qc, kc, vc, gc = to_chunks(q), to_chunks(k), to_chunks(v), to_chunks(glog)
    b = jnp.cumsum(gc, axis=-2)
    qt = qc * jnp.exp(b) * (DK ** -0.5)
    kt = kc * jnp.exp(-b)
    kd = kc * jnp.exp(b[..., -1:, :] - b)
    decay_end = jnp.exp(b[..., -1, :])
    tri = jnp.tril(jnp.ones((C, C), dtype=bool))
    a_intra = jnp.where(tri, jnp.einsum('nbhid,nbhjd->nbhij', qt, kt), 0.0)
    o_intra = jnp.einsum('nbhij,nbhje->nbhie', a_intra, vc)

    def step(state, inp):
        qt_n, kd_n, v_n, dec_n = inp
        o = jnp.einsum('bhid,bhde->bhie', qt_n, state)
        state = dec_n[..., None] * state + jnp.einsum('bhjd,bhje->bhde', kd_n, v_n)
        return state, o

    state0 = jnp.zeros((B, H, DK, DV), jnp.float32)
    _, o_inter = lax.scan(step, state0, (qt, kd, vc, decay_end))
    o = (o_intra + o_inter).transpose(1, 0, 3, 2, 4).reshape(B, S, H, DV)
    return o.astype(v.dtype)


def hybrid_layer(x, norm_g, w_in, att_q_gain, att_k_gain, pool_w, pool_scale,
                 gla_w_gate, gla_b_gate, gla_out_gain, w_out):
    B, S, _ = x.shape
    h = rms_norm(x, norm_g)
    proj = h @ w_in
    (aq, ak, av, az, iq, ik, iw, pu, pz, gq, gk, gv, gg, gz) = split_columns(proj)

    q = rms_norm(aq.reshape(B, S, ATT_HEADS, ATT_HEAD_DIM), att_q_gain) * (ATT_HEAD_DIM ** -0.5)
    k = rms_norm(ak.reshape(B, S, ATT_HEADS, ATT_HEAD_DIM), att_k_gain)
    v = av.reshape(B, S, ATT_HEADS, ATT_HEAD_DIM)
    iq = iq.reshape(B, S, IDX_HEADS, IDX_DIM)
    iw = iw * (IDX_HEADS ** -0.5)
    ya = sparse_attention(q, k, v, iq, ik, iw).reshape(B, S, ATT_WIDTH) * jax.nn.silu(az)

    yb = pool_mixer(pu, pool_w, pool_scale) * jax.nn.silu(pz)

    glog = jax.nn.log_sigmoid((gg @ gla_w_gate + gla_b_gate).astype(jnp.float32)) / GLA_TAU
    glog = glog.reshape(B, S, GLA_HEADS, GLA_DK)
    yc = gla_chunked(gq.reshape(B, S, GLA_HEADS, GLA_DK), gk.reshape(B, S, GLA_HEADS, GLA_DK),
                     gv.reshape(B, S, GLA_HEADS, GLA_DV), glog)
    yc = rms_norm(yc, gla_out_gain).reshape(B, S, GLA_VAL_WIDTH) * jax.nn.silu(gz)

    y = jnp.concatenate([ya, yb, yc], axis=-1) @ w_out
    return x + y


def setup_inputs(seed: int = 0) -> dict:
    key = jax.random.key(seed)
    ks = jax.random.split(key, 12)
    f32 = jnp.float32
    x = jax.random.normal(ks[0], (BATCH, SEQ, D_MODEL), f32)
    norm_g = 1.0 + 0.05 * jax.random.normal(ks[1], (DEPTH, D_MODEL), f32)
    w_in = jax.random.normal(ks[2], (DEPTH, D_MODEL, IN_WIDTH), f32) * D_MODEL ** -0.5
    att_q_gain = 1.0 + 0.05 * jax.random.normal(ks[3], (DEPTH, ATT_HEAD_DIM), f32)
    att_k_gain = 1.0 + 0.05 * jax.random.normal(ks[4], (DEPTH, ATT_HEAD_DIM), f32)
    pool_w = jax.random.normal(ks[5], (DEPTH, POOL_GROUPS, POOL_GROUP_DIM, POOL_GROUP_DIM), f32) * POOL_GROUP_DIM ** -0.5
    pool_scale = 1.0 + 0.1 * jax.random.normal(ks[6], (DEPTH, POOL_WIDTH), f32)
    gla_w_gate = jax.random.normal(ks[7], (DEPTH, GLA_GATE_RANK, GLA_KEY_WIDTH), f32) * GLA_GATE_RANK ** -0.5
    gla_b_gate = 0.1 * jax.random.normal(ks[8], (DEPTH, GLA_KEY_WIDTH), f32)
    gla_out_gain = 1.0 + 0.05 * jax.random.normal(ks[9], (DEPTH, GLA_DV), f32)
    w_out = jax.random.normal(ks[10], (DEPTH, MIX_WIDTH, D_MODEL), f32) * MIX_WIDTH ** -0.5
    return {"x": x, "norm_g": norm_g, "w_in": w_in, "att_q_gain": att_q_gain,
            "att_k_gain": att_k_gain, "pool_w": pool_w, "pool_scale": pool_scale,
            "gla_w_gate": gla_w_gate, "gla_b_gate": gla_b_gate,
            "gla_out_gain": gla_out_gain, "w_out": w_out}


def reference(x, norm_g, w_in, att_q_gain, att_k_gain, pool_w, pool_scale,
              gla_w_gate, gla_b_gate, gla_out_gain, w_out):
    for l in range(DEPTH):
        x = hybrid_layer(x, norm_g[l], w_in[l], att_q_gain[l], att_k_gain[l], pool_w[l],
                         pool_scale[l], gla_w_gate[l], gla_b_gate[l], gla_out_gain[l], w_out[l])
    return x
```

```cpp
#include <hip/hip_runtime.h>
#include <hip/hip_cooperative_groups.h>
#include <cstdio>
#include <cstdint>
namespace cg = cooperative_groups;
namespace pg8 {
#define PG8_LAS __attribute__((address_space(3)))
typedef unsigned short bf16_t;
typedef short bf16x8 __attribute__((ext_vector_type(8)));
typedef float f32x4 __attribute__((ext_vector_type(4)));
typedef unsigned u32x4 __attribute__((ext_vector_type(4)));
constexpr int BM = 256, BK = 64, HALF = 128, HTB = HALF * BK * 2  , STAGE_BYTES = 8 * HTB, NXCD = 8, WGM = 8;

__host__ __device__ __forceinline__ int lds_byte(int r, int c) { const int st = (r >> 4) * 2 + (c >> 5), rr = r & 15, cc = c & 31, ob = rr * 64 + cc * 2; return st * 1024 + (ob ^ (((ob >> 9) & 1) << 5)); }
__host__ __device__ __forceinline__ void stage_rc(int b, int& R, int& C) { const int st = b / 1024, sb = b % 1024, swz = sb ^ (((sb >> 9) & 1) << 5); R = (st >> 1) * 16 + swz / 64; C = (st & 1) * 32 + (swz % 64) / 2; }
__host__ __device__ __forceinline__ int perm32(int rho) { const int n = rho >> 4, i = rho & 15; return 8 * (i >> 2) + 4 * n + (i & 3); }

struct Unit { int pm, pn; };
struct Gemm { const bf16_t* A; const bf16_t* Bt; int M, N, K; };

struct StaticOrder {
    int nM, nN, nwg, G, c;
    __host__ __device__ void init(int M, int N, int G_, int c_) { nM = M / BM; nN = N / BM; nwg = nM * nN; G = G_; c = c_; }
    __host__ __device__ bool next(int i, Unit& u) const {
        const long L = (long)i * G + c; if (L >= nwg) return false;
        int wgid = (int)L; { const int q = nwg / NXCD, r = nwg % NXCD, xcd = wgid % NXCD, off = wgid / NXCD; wgid = (xcd < r ? xcd * (q + 1) : r * (q + 1) + (xcd - r) * q) + off; }
        const int nig = WGM * nN, gid = wgid / nig, fm = gid * WGM, gsz = (nM - fm) < WGM ? (nM - fm) : WGM;
        u.pm = fm + ((wgid % nig) % gsz); u.pn = (wgid % nig) / gsz; return true;
    }
    __device__ __forceinline__ void a_ready(const Unit&) const {}
    __device__ __forceinline__ void done(const Unit&) const {}
};
__device__ __forceinline__ unsigned cvt_pk_bf16(float lo, float hi) { unsigned r; asm volatile("v_cvt_pk_bf16_f32 %0, %1, %2" : "=v"(r) : "v"(lo), "v"(hi)); return r; }
template <class Epi, class Sched, bool STAMP = false>
__device__ __forceinline__ void gemm_phase(PG8_LAS unsigned char* lds, const Gemm g, const Sched& S, const Epi& E, unsigned long long* stamps) {
    const int tid = threadIdx.x, wid = __builtin_amdgcn_readfirstlane(tid >> 6), lane = tid & 63, wr = wid >> 2, wc = wid & 3, fr = lane & 15, fq = lane >> 4;
    const int K = g.K, nt = K / BK;
    int ts_lo = 0, ts_hi = 0, nts = 0; const unsigned long long rt_entry = STAMP ? (unsigned long long)wall_clock64() : 0ull;
#define PG8_STAMP() do { if (STAMP && wid == 0 && nts < 64) { const unsigned long long _c = (unsigned long long)clock64(); \
        ts_lo = (lane == nts) ? (int)(unsigned)_c : ts_lo; ts_hi = (lane == nts) ? (int)(unsigned)(_c >> 32) : ts_hi; ++nts; } } while (0)
    PG8_STAMP();
    unsigned voffA[2], voffB[2];
#pragma unroll
    for (int i = 0; i < 2; ++i) { int R, C; stage_rc(tid * 16 + i * 8192, R, C); const int Rb = Epi::PERM ? ((R & ~31) + perm32(R & 31)) : R;
        voffA[i] = (unsigned)(R * K + C) * 2u; voffB[i] = (unsigned)(Rb * K + C) * 2u; }
    const size_t kstep = (size_t)(BK * 2);
    const size_t hstep = (size_t)HALF * K * 2;
    const size_t tstep = 2 * hstep;
    const unsigned ldsw = (unsigned)wid * 1024u;
    const int aoff = lds_byte(wr * 64 + fr, fq * 8), boff = lds_byte(wc * 32 + fr, fq * 8);
#define PG8_SA(b, h) (((b) * 2 + (h)) * HTB)
#define PG8_SB(b, h) ((4 + (b) * 2 + (h)) * HTB)
#define PG8_STAGE(bufoff, gbase, voff) do { _Pragma("unroll") for (int _i = 0; _i < 2; ++_i) \
        __builtin_amdgcn_global_load_lds((const unsigned*)((const char*)(gbase) + (voff)[_i]), (PG8_LAS unsigned*)(lds + (bufoff) + ldsw + _i * 8192), 16, 0, 0); } while (0)
#define PG8_LDA(dst, b, h) do { _Pragma("unroll") for (int m = 0; m < 4; ++m) _Pragma("unroll") for (int k = 0; k < 2; ++k) dst[m][k] = *(const PG8_LAS bf16x8*)(lds + PG8_SA(b, h) + aoff + m * 2048 + k * 1024); } while (0)
#define PG8_LDB(dst, b, h) do { _Pragma("unroll") for (int n = 0; n < 2; ++n) _Pragma("unroll") for (int k = 0; k < 2; ++k) dst[n][k] = *(const PG8_LAS bf16x8*)(lds + PG8_SB(b, h) + boff + n * 2048 + k * 1024); } while (0)
#define PG8_MMA(ai, bj, At, Bt) do { __builtin_amdgcn_s_setprio(1); _Pragma("unroll") for (int m = 0; m < 4; ++m) _Pragma("unroll") for (int n = 0; n < 2; ++n) _Pragma("unroll") for (int k = 0; k < 2; ++k) \
        acc[ai][bj][m][n] = __builtin_amdgcn_mfma_f32_16x16x32_bf16(Bt[n][k], At[m][k], acc[ai][bj][m][n], 0, 0, 0); __builtin_amdgcn_s_setprio(0); } while (0)
#define PG8_WAIT_V(n) asm volatile("s_waitcnt vmcnt(" #n ")" ::: "memory")
#define PG8_WAIT_L(n) asm volatile("s_waitcnt lgkmcnt(" #n ")" ::: "memory")
#define PG8_BAR __builtin_amdgcn_s_barrier()
#define PG8_SCHED __builtin_amdgcn_sched_barrier(0)
    Unit cur, nxt; int ui = 0;
    if (!S.next(0, cur)) return;
    f32x4 acc[2][2][4][2];
#pragma unroll
    for (int a = 0; a < 2; ++a)
#pragma unroll
        for (int b = 0; b < 2; ++b)
#pragma unroll
            for (int m = 0; m < 4; ++m)
#pragma unroll
                for (int n = 0; n < 2; ++n) acc[a][b][m][n] = (f32x4){0.f, 0.f, 0.f, 0.f};
    bf16x8 At[4][2], B0[2][2], B1[2][2];
    const char* cA = (const char*)g.A + (size_t)cur.pm * tstep; const char* cB = (const char*)g.Bt + (size_t)cur.pn * tstep;
    S.a_ready(cur);
    PG8_STAGE(PG8_SB(0, 0), cB, voffB); PG8_STAGE(PG8_SA(0, 0), cA, voffA); PG8_STAGE(PG8_SB(0, 1), cB + hstep, voffB); PG8_STAGE(PG8_SA(0, 1), cA + hstep, voffA);
    if (wr == 1) PG8_BAR;
    PG8_WAIT_V(4); PG8_BAR;
    PG8_STAGE(PG8_SB(1, 0), cB + kstep, voffB); PG8_STAGE(PG8_SA(1, 0), cA + kstep, voffA); PG8_STAGE(PG8_SB(1, 1), cB + hstep + kstep, voffB);
    PG8_WAIT_V(6); PG8_BAR;
    PG8_STAMP();
    for (;;) {
        const bool has_next = S.next(ui + 1, nxt);
        const char* nA = has_next ? (const char*)g.A + (size_t)nxt.pm * tstep : cA; const char* nB = has_next ? (const char*)g.Bt + (size_t)nxt.pn * tstep : cB;
        for (int t = 0; t < nt; t += 2) {
            const bool last = (t == nt - 2);
            const char* a1 = cA + (size_t)(t + 1) * kstep;
            const char* a2 = last ? nA : cA + (size_t)(t + 2) * kstep; const char* b2 = last ? nB : cB + (size_t)(t + 2) * kstep;
            const char* a3 = a2 + kstep; const char* b3 = b2 + kstep;
            if (last && has_next) S.a_ready(nxt);
            PG8_LDB(B0, 0, 0); PG8_SCHED; PG8_LDA(At, 0, 0); PG8_STAGE(PG8_SA(1, 1), a1 + hstep, voffA);
            PG8_WAIT_L(8); PG8_BAR; PG8_WAIT_L(0); PG8_MMA(0, 0, At, B0); PG8_BAR; PG8_SCHED;
            PG8_LDB(B1, 0, 1); PG8_STAGE(PG8_SB(0, 0), b2, voffB);
            PG8_BAR; PG8_WAIT_L(0); PG8_MMA(0, 1, At, B1); PG8_BAR;
            PG8_LDA(At, 0, 1); PG8_STAGE(PG8_SA(0, 0), a2, voffA);
            PG8_BAR; PG8_WAIT_L(0); PG8_MMA(1, 0, At, B0); PG8_BAR; PG8_SCHED;
            PG8_STAGE(PG8_SB(0, 1), b2 + hstep, voffB);
            PG8_WAIT_V(6); PG8_BAR; PG8_MMA(1, 1, At, B1); PG8_BAR;
            PG8_LDB(B0, 1, 0); PG8_SCHED; PG8_LDA(At, 1, 0); PG8_STAGE(PG8_SA(0, 1), a2 + hstep, voffA);
            PG8_WAIT_L(8); PG8_BAR; PG8_WAIT_L(0); PG8_MMA(0, 0, At, B0); PG8_BAR; PG8_SCHED;
            PG8_LDB(B1, 1, 1); PG8_STAGE(PG8_SB(1, 0), b3, voffB);
            PG8_BAR; PG8_WAIT_L(0); PG8_MMA(0, 1, At, B1); PG8_BAR;
            PG8_LDA(At, 1, 1); PG8_STAGE(PG8_SA(1, 0), a3, voffA);
            PG8_BAR; PG8_WAIT_L(0); PG8_MMA(1, 0, At, B0); PG8_BAR; PG8_SCHED;
            PG8_STAGE(PG8_SB(1, 1), b3 + hstep, voffB);
            PG8_WAIT_V(6); PG8_BAR; PG8_MMA(1, 1, At, B1); PG8_BAR;
        }
        PG8_STAMP();
        if constexpr (!Epi::AFTER_DRAIN) { E(acc, cur, wr, wc, fr, fq); S.done(cur); }
        PG8_STAMP();
        if (!has_next) break;
#pragma unroll
        for (int a = 0; a < 2; ++a)
#pragma unroll
            for (int b = 0; b < 2; ++b)
#pragma unroll
                for (int m = 0; m < 4; ++m)
#pragma unroll
                    for (int n = 0; n < 2; ++n) acc[a][b][m][n] = (f32x4){0.f, 0.f, 0.f, 0.f};
        cur = nxt; cA = nA; cB = nB; ++ui;
    }
    PG8_WAIT_V(0);
    if (wr == 0) PG8_BAR;
    PG8_BAR;
    if constexpr (Epi::AFTER_DRAIN) { E.fused(acc, cur, wr, wc, fr, fq, lds, wid, lane); S.done(cur); }
    PG8_STAMP();
    if (STAMP && wid == 0) { stamps[lane] = lane < nts ? (((unsigned long long)(unsigned)ts_hi << 32) | (unsigned)ts_lo) : 0ull;
        if (lane == 62) stamps[62] = rt_entry; if (lane == 63) stamps[63] = (unsigned long long)wall_clock64(); }
#undef PG8_STAMP
#undef PG8_SA
#undef PG8_SB
#undef PG8_STAGE
#undef PG8_LDA
#undef PG8_LDB
#undef PG8_MMA
#undef PG8_WAIT_V
#undef PG8_WAIT_L
#undef PG8_BAR
#undef PG8_SCHED
}
}
#define LAS __attribute__((address_space(3)))
typedef unsigned short bf16_t;
typedef short bf16x8 __attribute__((ext_vector_type(8)));
typedef float f32x4 __attribute__((ext_vector_type(4)));
typedef unsigned u32x4 __attribute__((ext_vector_type(4)));
typedef unsigned u32x2 __attribute__((ext_vector_type(2)));
typedef unsigned long long u64;

#ifndef MULTI_LAUNCH
#define MULTI_LAUNCH 1
#endif

constexpr int T_TOK = 65536, SEQ = 2048, NBATCH = 32, DM = 1024, NP = 3840, INW = 3540;
constexpr int C_Q = 0, C_K = 384, C_V = 768, C_AZ = 1152, C_IQ = 1536, C_IK = 1792, C_IW = 1856, C_PU = 1920, C_PZ = 2176,
              C_GQ = 2432, C_GK = 2624, C_GV = 2816, C_GG = 3200, C_GZ = 3392;
constexpr int LDS_BYTES = 139264;
constexpr int LDS_QUEUE = 135168;
constexpr size_t MiB = 1u << 20;
constexpr size_t WS_CTL = 0, WS_WIN = 1 * MiB, WS_WOUT = 16 * MiB, WS_RINV = 20 * MiB, WS_MASK = 24 * MiB, WS_XB = 40 * MiB,
                 WS_MIX = 168 * MiB, WS_PROJ = 296 * MiB, WS_END = 776 * MiB;
constexpr int N_PHASES = 10;
constexpr float LOG2E = 1.4426950408889634f;

struct Params {
    const float* x; const float* norm_g; const float* w_in; const float* qg; const float* kg; const float* pool_w; const float* pool_scale;
    const float* wgate; const float* bgate; const float* ogain; const float* w_out; float* out; unsigned char* ws; int lo, hi;
};

__device__ __forceinline__ float bf_lo(unsigned w) { return __uint_as_float(w << 16); }
__device__ __forceinline__ float bf_hi(unsigned w) { return __uint_as_float(w & 0xffff0000u); }
__device__ __forceinline__ unsigned pk2(float lo, float hi) { return pg8::cvt_pk_bf16(lo, hi); }
__device__ __forceinline__ void unpack8(const u32x4 w, float (&f)[8]) {
    f[0] = bf_lo(w.x); f[1] = bf_hi(w.x); f[2] = bf_lo(w.y); f[3] = bf_hi(w.y); f[4] = bf_lo(w.z); f[5] = bf_hi(w.z); f[6] = bf_lo(w.w); f[7] = bf_hi(w.w);
}
__device__ __forceinline__ u32x4 pack8(const float (&f)[8]) { u32x4 w; w.x = pk2(f[0], f[1]); w.y = pk2(f[2], f[3]); w.z = pk2(f[4], f[5]); w.w = pk2(f[6], f[7]); return w; }
__device__ __forceinline__ f32x4 mfma16(bf16x8 a, bf16x8 b, f32x4 c) { return __builtin_amdgcn_mfma_f32_16x16x32_bf16(a, b, c, 0, 0, 0); }
__device__ __forceinline__ bf16x8 as_bf8(u32x4 w) { return __builtin_bit_cast(bf16x8, w); }
__device__ __forceinline__ float silu_f(float z) { return z / (1.0f + __expf(-z)); }
__device__ __forceinline__ float wave_sum(float v) {
#pragma unroll
    for (int o = 1; o < 64; o <<= 1) v += __shfl_xor(v, o);
    return v;
}
#define LDS_WAIT() asm volatile("s_waitcnt lgkmcnt(0)" ::: "memory")

struct EpiProj {
    static constexpr bool PERM = true, AFTER_DRAIN = false;
    bf16_t* O; const float* rinv;
    __device__ __forceinline__ void operator()(const pg8::f32x4 (&acc)[2][2][4][2], const pg8::Unit& u, int wr, int wc, int fr, int fq) const {
        const int row0 = u.pm * 256 + wr * 64 + fr, col0 = u.pn * 256 + wc * 32 + 8 * fq;
#pragma unroll
        for (int ai = 0; ai < 2; ++ai)
#pragma unroll
            for (int m = 0; m < 4; ++m) {
                asm volatile("" ::: "memory");
                const int row = row0 + ai * 128 + m * 16; const float rs = rinv[row];
                bf16_t* rowp = O + (size_t)row * NP + col0;
#pragma unroll
                for (int bj = 0; bj < 2; ++bj) {
                    const pg8::f32x4 v0 = acc[ai][bj][m][0] * rs, v1 = acc[ai][bj][m][1] * rs;
                    u32x4 w; w.x = pk2(v0[0], v0[1]); w.y = pk2(v0[2], v0[3]); w.z = pk2(v1[0], v1[1]); w.w = pk2(v1[2], v1[3]);
                    *(u32x4*)(rowp + bj * 128) = w;
                }
            }
    }
};
struct EpiOut {
    static constexpr bool PERM = false, AFTER_DRAIN = false;
    const float* xin; float* out;
    __device__ __forceinline__ void operator()(const pg8::f32x4 (&acc)[2][2][4][2], const pg8::Unit& u, int wr, int wc, int fr, int fq) const {
        const int row0 = u.pm * 256 + wr * 64 + fr, col0 = u.pn * 256 + wc * 32 + 4 * fq;
#pragma unroll
        for (int ai = 0; ai < 2; ++ai)
#pragma unroll
            for (int m = 0; m < 4; ++m) {
                asm volatile("" ::: "memory");
                const size_t off = (size_t)(row0 + ai * 128 + m * 16) * DM + col0;
#pragma unroll
                for (int bj = 0; bj < 2; ++bj)
#pragma unroll
                    for (int n = 0; n < 2; ++n) {
                        const pg8::f32x4 xv = *(const pg8::f32x4*)(xin + off + bj * 128 + n * 16);
                        *(pg8::f32x4*)(out + off + bj * 128 + n * 16) = xv + acc[ai][bj][m][n];
                    }
            }
    }
};

__device__ __forceinline__ float win_eff(const Params& p, int l, int k, int n) {
    const float* W = p.w_in + ((size_t)l * DM + k) * INW;
    if (n < 1860) return W[n];
    if (n < C_PU) return 0.f;
    if (n < C_PZ) {
        const int gi = (n - C_PU) >> 6, d = (n - C_PU) & 63;
        const float* pw = p.pool_w + ((size_t)(l * 4 + gi) * 64) * 64 + d; const float* wr = W + 1860 + gi * 64; float s = 0.f;
        for (int c = 0; c < 64; ++c) s += wr[c] * pw[c * 64];
        return s * p.pool_scale[l * 256 + gi * 64 + d];
    }
    if (n < C_GQ) return W[2116 + (n - C_PZ)];
    if (n < C_GK) return W[2372 + (n - C_GQ)];
    if (n < C_GV) return W[2564 + (n - C_GK)];
    if (n < C_GG) return W[2756 + (n - C_GV)];
    if (n < C_GZ) {
        const int j = n - C_GG; const float* wg = p.wgate + (size_t)l * 16 * 192 + j; float s = 0.f;
        for (int r = 0; r < 16; ++r) s += W[3140 + r] * wg[r * 192];
        return s;
    }
    if (n < 3776) return W[3156 + (n - C_GZ)];
    return 0.f;
}

__device__ __forceinline__ void phase_weights(const Params& p, LAS unsigned char* lds, int gw, int ngw, int wave, int lane) {
    LAS float* scr = (LAS float*)(lds + wave * 8704);
    bf16_t* WIN = (bf16_t*)(p.ws + WS_WIN); bf16_t* WOUT = (bf16_t*)(p.ws + WS_WOUT);
    constexpr int NI_IN = 2 * 16 * 120, NI_OUT = 2 * 16 * 32;
    for (int it = gw; it < NI_IN + NI_OUT; it += ngw) {
        const int nn = lane & 31;
        bf16_t* dst; int k0, n0, ldk = DM;
        if (it < NI_IN) {
            const int l = it / 1920, r = it % 1920, kb = r / 120, nb = r % 120; k0 = 64 * kb; n0 = 32 * nb;
#pragma unroll 4
            for (int i = 0; i < 32; ++i) { const int kk = 2 * i + (lane >> 5), k = k0 + kk; scr[kk * 33 + nn] = win_eff(p, l, k, n0 + nn) * p.norm_g[l * DM + k]; }
            dst = WIN + (size_t)l * NP * DM;
        } else {
            const int r0 = it - NI_IN, l = r0 / 512, r = r0 % 512, kb = r / 32, nb = r % 32; k0 = 64 * kb; n0 = 32 * nb;
            const float* W = p.w_out + (size_t)l * DM * DM;
#pragma unroll 4
            for (int i = 0; i < 32; ++i) { const int kk = 2 * i + (lane >> 5), k = k0 + kk; scr[kk * 33 + nn] = W[(size_t)k * DM + n0 + nn]; }
            dst = WOUT + (size_t)l * DM * DM;
        }
        LDS_WAIT();
        const int c = lane & 7;
#pragma unroll
        for (int j = 0; j < 4; ++j) {
            const int n = (lane >> 3) + 8 * j; const LAS float* s = scr + (8 * c) * 33 + n;
            u32x4 o; o.x = pk2(s[0 * 33], s[1 * 33]); o.y = pk2(s[2 * 33], s[3 * 33]); o.z = pk2(s[4 * 33], s[5 * 33]); o.w = pk2(s[6 * 33], s[7 * 33]);
            *(u32x4*)(dst + (size_t)(n0 + n) * ldk + k0 + 8 * c) = o;
        }
        LDS_WAIT();
    }
}
__device__ __forceinline__ void phase_prep_x(const Params& p, const float* src, int gw, int ngw, int lane) {
    bf16_t* xb = (bf16_t*)(p.ws + WS_XB); float* rinv = (float*)(p.ws + WS_RINV);
    for (int m = gw; m < T_TOK; m += ngw) {
        const f32x4* xr = (const f32x4*)(src + (size_t)m * DM) + lane;
        f32x4 v[4]; float s = 0.f;
#pragma unroll
        for (int j = 0; j < 4; ++j) { v[j] = xr[64 * j]; s += (v[j].x * v[j].x + v[j].y * v[j].y) + (v[j].z * v[j].z + v[j].w * v[j].w); }
        s = wave_sum(s);
        if (lane == 0) rinv[m] = 1.0f / sqrtf(s * (1.0f / DM) + 1e-6f);
        u32x2* o8 = (u32x2*)(xb + (size_t)m * DM) + lane;
#pragma unroll
        for (int j = 0; j < 4; ++j) { u32x2 w; w.x = pk2(v[j].x, v[j].y); w.y = pk2(v[j].z, v[j].w); o8[64 * j] = w; }
    }
}

__device__ __forceinline__ void qknorm_item(const Params& p, int l, int item, int tid) {
    bf16_t* proj = (bf16_t*)(p.ws + WS_PROJ);
    for (int idx = tid; idx < 64 * 96; idx += 512) {
        const int r = idx / 96, ch = idx % 96; const size_t row = (size_t)item * 64 + r;
        u32x4* ptr = (u32x4*)(proj + row * NP + ch * 8);
        float f[8]; unpack8(*ptr, f);
        float ss = 0.f;
#pragma unroll
        for (int i = 0; i < 8; ++i) ss += f[i] * f[i];
        ss += __shfl_xor(ss, 1); ss += __shfl_xor(ss, 2); ss += __shfl_xor(ss, 4);
        const float rn = 1.0f / sqrtf(ss * (1.0f / 64.0f) + 1e-6f);
        const bool isq = ch < 48; const float* gp = (isq ? p.qg : p.kg) + l * 64 + (ch & 7) * 8; const float sc = isq ? (0.125f * LOG2E) * rn : rn;
#pragma unroll
        for (int i = 0; i < 8; ++i) f[i] = f[i] * sc * gp[i];
        *ptr = pack8(f);
    }
}
__device__ __forceinline__ void pool_item(const Params& p, int item, int tid) {
    const bf16_t* proj = (const bf16_t*)(p.ws + WS_PROJ); bf16_t* mix = (bf16_t*)(p.ws + WS_MIX);
    for (int idx = tid; idx < 256 * 32; idx += 512) {
        const int r = idx >> 5, ch = idx & 31; const size_t row = (size_t)item * 256 + r; const int t = (int)(row & (SEQ - 1));
        const int w = 2 << (ch >> 3); const int cnt = (t + 1 < w) ? (t + 1) : w;
        const bf16_t* up = proj + row * NP + C_PU + ch * 8;
        float acc[8], u0[8], f[8];
        unpack8(*(const u32x4*)up, u0);
#pragma unroll
        for (int i = 0; i < 8; ++i) acc[i] = u0[i];
        for (int s = 1; s < cnt; ++s) { unpack8(*(const u32x4*)(up - (size_t)s * NP), f);
#pragma unroll
            for (int i = 0; i < 8; ++i) acc[i] += f[i]; }
        const float ic = 1.0f / (float)cnt;
        unpack8(*(const u32x4*)(proj + row * NP + C_PZ + ch * 8), f);
#pragma unroll
        for (int i = 0; i < 8; ++i) f[i] = (acc[i] * ic - u0[i]) * silu_f(f[i]);
        *(u32x4*)(mix + row * DM + 384 + ch * 8) = pack8(f);
    }
}

template <int NJ>
__device__ __forceinline__ u64 select_row(const LAS float* srow, int t, int lane) {
    unsigned u[NJ];
#pragma unroll
    for (int j = 0; j < NJ; ++j) {
        const int key = j * 64 + lane; const unsigned bits = __float_as_uint(srow[key]);
        const unsigned o = bits ^ ((bits >> 31) ? 0xFFFFFFFFu : 0x80000000u);
        u[j] = (key <= t) ? o : 0u;
    }
    unsigned prefix = 0u;
    for (int bit = 31; bit >= 0; --bit) {
        const unsigned cand = prefix | (1u << bit); int cnt = 0;
#pragma unroll
        for (int j = 0; j < NJ; ++j) { cnt += __popcll(__ballot(u[j] >= cand)); __builtin_amdgcn_sched_barrier(0); }
        if (cnt >= 256) prefix = cand;
        if (cnt == 256) break;
    }
    int cgt = 0;
#pragma unroll
    for (int j = 0; j < NJ; ++j) { cgt += __popcll(__ballot(u[j] > prefix)); __builtin_amdgcn_sched_barrier(0); }
    int need = 256 - cgt; u64 myword = 0ull;
#pragma unroll
    for (int j = 0; j < NJ; ++j) {
        const u64 gt = __ballot(u[j] > prefix); u64 eq = __ballot(u[j] == prefix); const int c = __popcll(eq); u64 take;
        if (c <= need) { take = eq; need -= c; }
        else { take = 0ull; while (need > 0) { const u64 low = eq & (~eq + 1ull); take |= low; eq ^= low; --need; } }
        const u64 w = gt | take;
        if (lane == j) myword = w;
        __builtin_amdgcn_sched_barrier(0);
    }
    return myword;
}
__device__ __forceinline__ void sel_item(const Params& p, int b, int qt, LAS unsigned char* lds, int tid, int wave, int lane) {
    u64* mask = (u64*)(p.ws + WS_MASK);
    const int t0 = qt * 16;
    if (t0 < 256) {
        const int n = tid >> 5, j = tid & 31, t = t0 + n, lo = j * 64; u64 w;
        if (t >= lo + 63) w = ~0ull; else if (t < lo) w = 0ull; else w = (2ull << (t - lo)) - 1ull;
        mask[((size_t)b * SEQ + t) * 32 + j] = w;
        return;
    }
    const bf16_t* pb = (const bf16_t*)(p.ws + WS_PROJ) + (size_t)b * SEQ * NP;
    LAS float* sc = (LAS float*)lds;
    const int n = lane & 15, g = lane >> 4;
    {
        bf16x8 bq[4][2]; float iw[4];
        const bf16_t* qrow = pb + (size_t)(t0 + n) * NP;
#pragma unroll
        for (int h = 0; h < 4; ++h) {
#pragma unroll
            for (int ks = 0; ks < 2; ++ks) bq[h][ks] = as_bf8(*(const u32x4*)(qrow + C_IQ + h * 64 + ks * 32 + g * 8));
        }
        { const u32x2 w = *(const u32x2*)(qrow + C_IW); iw[0] = 0.5f * bf_lo(w.x); iw[1] = 0.5f * bf_hi(w.x); iw[2] = 0.5f * bf_lo(w.y); iw[3] = 0.5f * bf_hi(w.y); }
        const int nkt = qt + 1;
        for (int kt = wave; kt < nkt; kt += 8) {
            const bf16_t* krow = pb + (size_t)(kt * 16 + n) * NP + C_IK + g * 8;
            const bf16x8 a0 = as_bf8(*(const u32x4*)krow), a1 = as_bf8(*(const u32x4*)(krow + 32));
            f32x4 s = {0.f, 0.f, 0.f, 0.f};
#pragma unroll
            for (int h = 0; h < 4; ++h) {
                f32x4 c = {0.f, 0.f, 0.f, 0.f};
                c = mfma16(a0, bq[h][0], c); c = mfma16(a1, bq[h][1], c);
#pragma unroll
                for (int r = 0; r < 4; ++r) s[r] += iw[h] * fmaxf(c[r], 0.f);
            }
            *(LAS f32x4*)(sc + n * 2052 + kt * 16 + 4 * g) = s;
        }
    }
    __syncthreads();
#pragma unroll 1
    for (int qi = 0; qi < 2; ++qi) {
        const int nq = wave + 8 * qi, t = t0 + nq, nw = (t >> 6) + 1; const LAS float* srow = sc + nq * 2052;
        u64 w;
        if (nw <= 8) w = select_row<8>(srow, t, lane);
        else if (nw <= 16) w = select_row<16>(srow, t, lane);
        else if (nw <= 24) w = select_row<24>(srow, t, lane);
        else w = select_row<32>(srow, t, lane);
        if (lane < 32) mask[((size_t)b * SEQ + t) * 32 + lane] = w;
    }
}

__device__ __forceinline__ void gla_seq(const Params& p, int l, int b, int h, LAS unsigned char* lds, int tid, int wave, int lane) {
    LAS bf16_t* bq = (LAS bf16_t*)(lds);
    LAS bf16_t* bk = (LAS bf16_t*)(lds + 9216);
    LAS bf16_t* bkdT = (LAS bf16_t*)(lds + 18432);
    LAS bf16_t* bvT = (LAS bf16_t*)(lds + 25344);
    LAS bf16_t* bST = (LAS bf16_t*)(lds + 39168);
    LAS float* fb = (LAS float*)(lds + 52992);
    LAS float* fs = (LAS float*)(lds + 65280);
    LAS float* fo = (LAS float*)(lds + 66816);
    for (int i = tid; i < 13248; i += 512) ((LAS unsigned*)lds)[i] = 0u;
    __syncthreads();
    const bf16_t* proj = (const bf16_t*)(p.ws + WS_PROJ); bf16_t* mix = (bf16_t*)(p.ws + WS_MIX);
    const size_t rowbase = (size_t)b * SEQ;
    const int n = lane & 15, g = lane >> 4, t_e = tid >> 3, dc = tid & 7;
    f32x4 st[3];
#pragma unroll
    for (int k = 0; k < 3; ++k) st[k] = (f32x4){0.f, 0.f, 0.f, 0.f};
    float bias8[8];
#pragma unroll
    for (int i = 0; i < 8; ++i) bias8[i] = (dc < 6) ? p.bgate[l * 192 + h * 48 + dc * 8 + i] : 0.f;
    u32x4 rz = {0, 0, 0, 0}, rq = {0, 0, 0, 0}, rk = {0, 0, 0, 0}, rv0 = {0, 0, 0, 0}, rv1 = {0, 0, 0, 0};
    const int v0t = tid / 12, v0e = tid % 12, v1t = (tid + 512) / 12, v1e = (tid + 512) % 12;
#define GLA_LOAD(cc) do { const size_t R_ = rowbase + 64 * (size_t)(cc); const bf16_t* rp_ = proj + (R_ + t_e) * NP; \
        if (dc < 6) { rz = *(const u32x4*)(rp_ + C_GG + h * 48 + dc * 8); rq = *(const u32x4*)(rp_ + C_GQ + h * 48 + dc * 8); rk = *(const u32x4*)(rp_ + C_GK + h * 48 + dc * 8); } \
        rv0 = *(const u32x4*)(proj + (R_ + v0t) * NP + C_GV + h * 96 + v0e * 8); \
        if (tid < 256) rv1 = *(const u32x4*)(proj + (R_ + v1t) * NP + C_GV + h * 96 + v1e * 8); } while (0)
    GLA_LOAD(0);
#pragma unroll 1
    for (int c = 0; c < 32; ++c) {
        const size_t R0 = rowbase + 64 * (size_t)c;
        if (dc < 6) {
            float z[8]; unpack8(rz, z);
#pragma unroll
            for (int i = 0; i < 8; ++i) { const float x = z[i] + bias8[i]; const float ls = fminf(x, 0.f) - __logf(1.0f + __expf(-fabsf(x))); fb[t_e * 48 + dc * 8 + i] = ls * 0.0625f; }
        }
        __syncthreads();
        float pre[8]; const int seg = tid / 48, d = tid - seg * 48;
        if (tid < 384) { float run = 0.f;
#pragma unroll
            for (int i = 0; i < 8; ++i) { run += fb[(8 * seg + i) * 48 + d]; pre[i] = run; }
            fs[seg * 48 + d] = run; }
        __syncthreads();
        if (tid < 384) { float off = 0.f;
#pragma unroll
            for (int s = 0; s < 8; ++s) off += (s < seg) ? fs[s * 48 + d] : 0.f;
#pragma unroll
            for (int i = 0; i < 8; ++i) fb[(8 * seg + i) * 48 + d] = pre[i] + off; }
        __syncthreads();
        if (dc < 6) {
            float q[8], k[8], qt[8], kt[8]; unpack8(rq, q); unpack8(rk, k);
#pragma unroll
            for (int i = 0; i < 8; ++i) {
                const float bb = fb[t_e * 48 + dc * 8 + i], bl = fb[63 * 48 + dc * 8 + i];
                qt[i] = q[i] * __expf(bb) * 0.14433756729740643f; kt[i] = k[i] * __expf(-bb);
                const float kd = k[i] * __expf(bl - bb);
                bkdT[(dc * 8 + i) * 72 + t_e] = (bf16_t)(pk2(kd, 0.f) & 0xffffu);
            }
            *(LAS u32x4*)(bq + t_e * 72 + dc * 8) = pack8(qt); *(LAS u32x4*)(bk + t_e * 72 + dc * 8) = pack8(kt);
        }
        {
            const unsigned wv[4] = {rv0.x, rv0.y, rv0.z, rv0.w};
#pragma unroll
            for (int i = 0; i < 4; ++i) { bvT[(v0e * 8 + 2 * i) * 72 + v0t] = (bf16_t)(wv[i] & 0xffffu); bvT[(v0e * 8 + 2 * i + 1) * 72 + v0t] = (bf16_t)(wv[i] >> 16); }
            if (tid < 256) { const unsigned wu[4] = {rv1.x, rv1.y, rv1.z, rv1.w};
#pragma unroll
                for (int i = 0; i < 4; ++i) { bvT[(v1e * 8 + 2 * i) * 72 + v1t] = (bf16_t)(wu[i] & 0xffffu); bvT[(v1e * 8 + 2 * i + 1) * 72 + v1t] = (bf16_t)(wu[i] >> 16); } }
        }
        __syncthreads();
        if (c + 1 < 32) GLA_LOAD(c + 1);
        {
            const int it = wave & 3, eh = wave >> 2;
            bf16x8 qB[2];
#pragma unroll
            for (int ks = 0; ks < 2; ++ks) qB[ks] = as_bf8(*(const LAS u32x4*)(bq + (16 * it + n) * 72 + 32 * ks + 8 * g));
            f32x4 at[4];
#pragma unroll
            for (int jt = 0; jt < 4; ++jt) {
                f32x4 cc = {0.f, 0.f, 0.f, 0.f};
                if (jt <= it) {
                    const bf16x8 a0 = as_bf8(*(const LAS u32x4*)(bk + (16 * jt + n) * 72 + 8 * g)), a1 = as_bf8(*(const LAS u32x4*)(bk + (16 * jt + n) * 72 + 32 + 8 * g));
                    cc = mfma16(a0, qB[0], cc); cc = mfma16(a1, qB[1], cc);
                    if (jt == it) {
#pragma unroll
                        for (int r = 0; r < 4; ++r) if (4 * g + r > n) cc[r] = 0.f;
                    }
                }
                at[jt] = cc;
            }
            bf16x8 pf[2];
#pragma unroll
            for (int s2 = 0; s2 < 2; ++s2) { u32x4 w; w.x = pk2(at[2 * s2][0], at[2 * s2][1]); w.y = pk2(at[2 * s2][2], at[2 * s2][3]); w.z = pk2(at[2 * s2 + 1][0], at[2 * s2 + 1][1]); w.w = pk2(at[2 * s2 + 1][2], at[2 * s2 + 1][3]); pf[s2] = as_bf8(w); }
#pragma unroll
            for (int ei = 0; ei < 3; ++ei) {
                const int et = 3 * eh + ei; f32x4 oa = {0.f, 0.f, 0.f, 0.f};
#pragma unroll
                for (int s2 = 0; s2 < 2; ++s2) {
                    const u32x2 lo = *(const LAS u32x2*)(bvT + (16 * et + n) * 72 + 32 * s2 + 4 * g), hi = *(const LAS u32x2*)(bvT + (16 * et + n) * 72 + 32 * s2 + 16 + 4 * g);
                    u32x4 w; w.x = lo.x; w.y = lo.y; w.z = hi.x; w.w = hi.y;
                    oa = mfma16(as_bf8(w), pf[s2], oa);
                }
#pragma unroll
                for (int ks = 0; ks < 2; ++ks) oa = mfma16(as_bf8(*(const LAS u32x4*)(bST + (16 * et + n) * 72 + 32 * ks + 8 * g)), qB[ks], oa);
                *(LAS f32x4*)(fo + (16 * it + n) * 100 + 16 * et + 4 * g) = oa;
            }
#pragma unroll
            for (int kk = 0; kk < 3; ++kk) {
                const int tile = wave + 8 * kk;
                if (tile < 18) {
                    const int et = tile / 3, dtl = tile % 3; const float dec = __expf(fb[63 * 48 + 16 * dtl + n]);
                    f32x4 acc = st[kk] * dec;
#pragma unroll
                    for (int ks = 0; ks < 2; ++ks) acc = mfma16(as_bf8(*(const LAS u32x4*)(bvT + (16 * et + n) * 72 + 32 * ks + 8 * g)), as_bf8(*(const LAS u32x4*)(bkdT + (16 * dtl + n) * 72 + 32 * ks + 8 * g)), acc);
                    st[kk] = acc;
                }
            }
        }
        __syncthreads();
#pragma unroll
        for (int kk = 0; kk < 3; ++kk) {
            const int tile = wave + 8 * kk;
            if (tile < 18) { const int et = tile / 3, dtl = tile % 3;
#pragma unroll
                for (int r = 0; r < 4; ++r) bST[(16 * et + 4 * g + r) * 72 + 16 * dtl + n] = (bf16_t)(pk2(st[kk][r], 0.f) & 0xffffu); }
        }
        {
            const int e0 = dc * 12; float v[12];
#pragma unroll
            for (int j = 0; j < 3; ++j) { const f32x4 x = *(const LAS f32x4*)(fo + t_e * 100 + e0 + 4 * j); v[4 * j] = x[0]; v[4 * j + 1] = x[1]; v[4 * j + 2] = x[2]; v[4 * j + 3] = x[3]; }
            float ss = 0.f;
#pragma unroll
            for (int i = 0; i < 12; ++i) ss += v[i] * v[i];
            ss += __shfl_xor(ss, 1); ss += __shfl_xor(ss, 2); ss += __shfl_xor(ss, 4);
            const float rin = 1.0f / sqrtf(ss * (1.0f / 96.0f) + 1e-6f);
            const bf16_t* gzp = proj + (R0 + t_e) * NP + C_GZ + h * 96 + e0; const float* gn = p.ogain + l * 96 + e0;
            bf16_t* op = mix + (R0 + t_e) * DM + 640 + h * 96 + e0;
#pragma unroll
            for (int j = 0; j < 3; ++j) {
                const u32x2 zw = *(const u32x2*)(gzp + 4 * j);
                const float o0 = v[4 * j] * rin * gn[4 * j] * silu_f(bf_lo(zw.x)), o1 = v[4 * j + 1] * rin * gn[4 * j + 1] * silu_f(bf_hi(zw.x));
                const float o2 = v[4 * j + 2] * rin * gn[4 * j + 2] * silu_f(bf_lo(zw.y)), o3 = v[4 * j + 3] * rin * gn[4 * j + 3] * silu_f(bf_hi(zw.y));
                u32x2 w; w.x = pk2(o0, o1); w.y = pk2(o2, o3); *(u32x2*)(op + 4 * j) = w;
            }
        }
    }
#undef GLA_LOAD
    __syncthreads();
}

__device__ __forceinline__ void attn_unit(const Params& p, int b, int qb, LAS unsigned char* lds, int tid, int wave, int lane) {
    LAS u64* mk = (LAS u64*)lds;
    LAS bf16_t* KB = (LAS bf16_t*)(lds + 33792);
    LAS bf16_t* VT = (LAS bf16_t*)(lds + 33792 + 18432);
    const bf16_t* proj = (const bf16_t*)(p.ws + WS_PROJ); bf16_t* mix = (bf16_t*)(p.ws + WS_MIX); const u64* mask = (const u64*)(p.ws + WS_MASK);
    const int t0 = qb * 128, nt = 2 * qb + 2;
    const size_t rowb = (size_t)b * SEQ;
    __syncthreads();
    for (int idx = tid; idx < 128 * nt; idx += 512) { const int q = idx / nt, w = idx - q * nt; mk[q * 33 + w] = mask[(rowb + t0 + q) * 32 + w]; }
    __syncthreads();
    const int n = lane & 15, g = lane >> 4;
    const size_t qrow = rowb + t0 + 16 * wave + n;
    const int skey = tid >> 3, sc8 = tid & 7;
#pragma unroll 1
    for (int h = 0; h < 6; ++h) {
        bf16x8 qf[2];
#pragma unroll
        for (int ks = 0; ks < 2; ++ks) qf[ks] = as_bf8(*(const u32x4*)(proj + qrow * NP + C_Q + h * 64 + ks * 32 + g * 8));
        f32x4 o[4];
#pragma unroll
        for (int dt = 0; dt < 4; ++dt) o[dt] = (f32x4){0.f, 0.f, 0.f, 0.f};
        float m = -INFINITY, lsum = 0.f;
        const bf16_t* kp = proj + (rowb + skey) * NP + C_K + h * 64 + sc8 * 8;
        const bf16_t* vp = proj + (rowb + skey) * NP + C_V + h * 64 + sc8 * 8;
        u32x4 rk = *(const u32x4*)kp, rv = *(const u32x4*)vp;
#define ATT_STAGE(buf) do { *(LAS u32x4*)(KB + (buf) * 4608 + skey * 72 + sc8 * 8) = rk; LAS bf16_t* vt_ = VT + (buf) * 4352 + (sc8 * 8) * 68 + skey; \
            vt_[0] = (bf16_t)(rv.x & 0xffffu); vt_[68] = (bf16_t)(rv.x >> 16); vt_[136] = (bf16_t)(rv.y & 0xffffu); vt_[204] = (bf16_t)(rv.y >> 16); \
            vt_[272] = (bf16_t)(rv.z & 0xffffu); vt_[340] = (bf16_t)(rv.z >> 16); vt_[408] = (bf16_t)(rv.w & 0xffffu); vt_[476] = (bf16_t)(rv.w >> 16); } while (0)
        ATT_STAGE(0);
        __syncthreads();
#pragma unroll 1
        for (int kt = 0; kt < nt; ++kt) {
            if (kt + 1 < nt) { rk = *(const u32x4*)(kp + (size_t)(kt + 1) * 64 * NP); rv = *(const u32x4*)(vp + (size_t)(kt + 1) * 64 * NP); }
            const LAS bf16_t* Kb = KB + (kt & 1) * 4608; const LAS bf16_t* Vt = VT + (kt & 1) * 4352;
            const u64 mw = mk[(16 * wave + n) * 33 + kt];
            f32x4 s[4];
#pragma unroll
            for (int ks = 0; ks < 4; ++ks) {
                const bf16x8 a0 = as_bf8(*(const LAS u32x4*)(Kb + (16 * ks + n) * 72 + 8 * g)), a1 = as_bf8(*(const LAS u32x4*)(Kb + (16 * ks + n) * 72 + 32 + 8 * g));
                f32x4 c = {0.f, 0.f, 0.f, 0.f};
                c = mfma16(a0, qf[0], c); c = mfma16(a1, qf[1], c);
                s[ks] = c;
            }
            const unsigned mlo = (unsigned)(mw >> (4 * g)), mhi = (unsigned)(mw >> (32 + 4 * g));
            float mx = -INFINITY;
#pragma unroll
            for (int ks = 0; ks < 4; ++ks)
#pragma unroll
                for (int r = 0; r < 4; ++r) {
                    const unsigned bitv = (ks < 2) ? ((mlo >> (16 * ks + r)) & 1u) : ((mhi >> (16 * (ks - 2) + r)) & 1u);
                    const float v = bitv ? s[ks][r] : -INFINITY; s[ks][r] = v; mx = fmaxf(mx, v);
                }
            mx = fmaxf(mx, __shfl_xor(mx, 16)); mx = fmaxf(mx, __shfl_xor(mx, 32));
            const float mnew = fmaxf(m, mx), muse = (mnew == -INFINITY) ? 0.f : mnew;
            const float alpha = __builtin_amdgcn_exp2f(m - muse);
            float ps = 0.f;
#pragma unroll
            for (int ks = 0; ks < 4; ++ks)
#pragma unroll
                for (int r = 0; r < 4; ++r) { const float pv = __builtin_amdgcn_exp2f(s[ks][r] - muse); s[ks][r] = pv; ps += pv; }
            lsum = lsum * alpha + ps; m = mnew;
#pragma unroll
            for (int dt = 0; dt < 4; ++dt) o[dt] = o[dt] * alpha;
            bf16x8 pf[2];
#pragma unroll
            for (int s2 = 0; s2 < 2; ++s2) { u32x4 w; w.x = pk2(s[2 * s2][0], s[2 * s2][1]); w.y = pk2(s[2 * s2][2], s[2 * s2][3]); w.z = pk2(s[2 * s2 + 1][0], s[2 * s2 + 1][1]); w.w = pk2(s[2 * s2 + 1][2], s[2 * s2 + 1][3]); pf[s2] = as_bf8(w); }
#pragma unroll
            for (int dt = 0; dt < 4; ++dt)
#pragma unroll
                for (int s2 = 0; s2 < 2; ++s2) {
                    const u32x2 lo = *(const LAS u32x2*)(Vt + (16 * dt + n) * 68 + 32 * s2 + 4 * g), hi = *(const LAS u32x2*)(Vt + (16 * dt + n) * 68 + 32 * s2 + 16 + 4 * g);
                    u32x4 w; w.x = lo.x; w.y = lo.y; w.z = hi.x; w.w = hi.y;
                    o[dt] = mfma16(as_bf8(w), pf[s2], o[dt]);
                }
            if (kt + 1 < nt) ATT_STAGE((kt + 1) & 1);
            __syncthreads();
        }
#undef ATT_STAGE
        float lt = lsum; lt += __shfl_xor(lt, 16); lt += __shfl_xor(lt, 32);
        const float inv = 1.0f / lt;
        const bf16_t* azp = proj + qrow * NP + C_AZ + h * 64 + 4 * g; bf16_t* op = mix + qrow * DM + h * 64 + 4 * g;
#pragma unroll
        for (int dt = 0; dt < 4; ++dt) {
            const u32x2 zw = *(const u32x2*)(azp + 16 * dt);
            const float o0 = o[dt][0] * inv * silu_f(bf_lo(zw.x)), o1 = o[dt][1] * inv * silu_f(bf_hi(zw.x)), o2 = o[dt][2] * inv * silu_f(bf_lo(zw.y)), o3 = o[dt][3] * inv * silu_f(bf_hi(zw.y));
            u32x2 w; w.x = pk2(o0, o1); w.y = pk2(o2, o3); *(u32x2*)(op + 16 * dt) = w;
        }
    }
}

__global__ void __launch_bounds__(512, 2) mega_fwd(Params pin) {
    extern __shared__ __attribute__((aligned(16))) unsigned char lds_raw[];
    LAS unsigned char* lds = (LAS unsigned char*)lds_raw;
    cg::grid_group grid = cg::this_grid();
#pragma unroll 1
    for (int ph = pin.lo; ph < pin.hi; ++ph) {
        int tid = threadIdx.x; asm volatile("" : "+v"(tid));
        Params p = pin; { unsigned char* w_ = pin.ws; asm volatile("" : "+s"(w_)); p.ws = w_; }
        const int lane = tid & 63, wave = __builtin_amdgcn_readfirstlane(tid >> 6);
        const int G = gridDim.x, bid = blockIdx.x;
        const int gw = bid * 8 + wave, ngw = G * 8;
        bf16_t* XB = (bf16_t*)(p.ws + WS_XB); bf16_t* PROJ = (bf16_t*)(p.ws + WS_PROJ); bf16_t* MIX = (bf16_t*)(p.ws + WS_MIX); float* RINV = (float*)(p.ws + WS_RINV);
        if (ph == 0) {
            phase_weights(p, lds, gw, ngw, wave, lane);
            phase_prep_x(p, p.x, gw, ngw, lane);
        } else {
            const int l = (ph - 1) / 5, sub = (ph - 1) % 5;
            if (sub == 0) {
                pg8::Gemm gm{XB, (const bf16_t*)(p.ws + WS_WIN) + (size_t)l * NP * DM, T_TOK, NP, DM};
                pg8::StaticOrder S; S.init(T_TOK, NP, G, bid);
                EpiProj E{PROJ, RINV};
                pg8::gemm_phase<EpiProj, pg8::StaticOrder>(lds, gm, S, E, nullptr);
            } else if (sub == 1) {
                for (int gi = bid; gi < 128; gi += G) gla_seq(p, l, gi >> 2, gi & 3, lds, tid, wave, lane);
                unsigned* ctr = (unsigned*)(p.ws + WS_CTL) + 64 * l;
                volatile LAS unsigned* qw = (volatile LAS unsigned*)(lds + LDS_QUEUE);
                for (;;) {
                    __syncthreads();
                    if (tid == 0) qw[0] = atomicAdd(ctr, 1u);
                    __syncthreads();
                    const int item = (int)qw[0];
                    if (item >= 4096 + 1024 + 256) break;
                    if (item < 4096) sel_item(p, item & 31, 127 - (item >> 5), lds, tid, wave, lane);
                    else if (item < 5120) qknorm_item(p, l, item - 4096, tid);
                    else pool_item(p, item - 5120, tid);
                }
            } else if (sub == 2) {
                for (int pi = bid; pi < 256; pi += G) {
                    const int b = pi >> 3, pp = pi & 7;
                    attn_unit(p, b, 15 - pp, lds, tid, wave, lane);
                    attn_unit(p, b, pp, lds, tid, wave, lane);
                }
            } else if (sub == 3) {
                pg8::Gemm gm{MIX, (const bf16_t*)(p.ws + WS_WOUT) + (size_t)l * DM * DM, T_TOK, DM, DM};
                pg8::StaticOrder S; S.init(T_TOK, DM, G, bid);
                EpiOut E{l == 0 ? p.x : (const float*)p.out, p.out};
                pg8::gemm_phase<EpiOut, pg8::StaticOrder>(lds, gm, S, E, nullptr);
            } else {
                if (l == 0) phase_prep_x(p, p.out, gw, ngw, lane);
            }
        }
        if (ph + 1 < pin.hi) grid.sync();
    }
}

extern "C" void kernel_launch(void* const* d_in, const int* in_sizes, int n_in, void* d_out, int out_size, void* d_ws, size_t ws_size, hipStream_t stream) {
    static int grid_blocks = 0;
    if (!grid_blocks) {
        if (n_in != 11 || ws_size < WS_END) { fprintf(stderr, "kernel_launch: unexpected inputs (n_in %d, ws %zu)\n", n_in, ws_size); return; }
        if (hipFuncSetAttribute((const void*)mega_fwd, hipFuncAttributeMaxDynamicSharedMemorySize, LDS_BYTES) != hipSuccess) { fprintf(stderr, "kernel_launch: hipFuncSetAttribute failed\n"); return; }
        int dev = 0, cus = 0, per_cu = 0;
        hipGetDevice(&dev); hipDeviceGetAttribute(&cus, hipDeviceAttributeMultiprocessorCount, dev);
        hipOccupancyMaxActiveBlocksPerMultiprocessor(&per_cu, mega_fwd, 512, LDS_BYTES);
        if (per_cu < 1) { fprintf(stderr, "kernel_launch: occupancy query says 0 blocks per CU\n"); return; }
        grid_blocks = cus * per_cu; if (grid_blocks > 256) grid_blocks = 256;
    }
    Params p{};
    p.x = (const float*)d_in[0]; p.norm_g = (const float*)d_in[1]; p.w_in = (const float*)d_in[2]; p.qg = (const float*)d_in[3]; p.kg = (const float*)d_in[4];
    p.pool_w = (const float*)d_in[5]; p.pool_scale = (const float*)d_in[6]; p.wgate = (const float*)d_in[7]; p.bgate = (const float*)d_in[8]; p.ogain = (const float*)d_in[9];
    p.w_out = (const float*)d_in[10]; p.out = (float*)d_out; p.ws = (unsigned char*)d_ws;
    hipMemsetAsync((char*)d_ws + WS_CTL, 0, 4096, stream);
#if MULTI_LAUNCH
    for (int ph = 0; ph < N_PHASES; ++ph) { p.lo = ph; p.hi = ph + 1; hipLaunchKernelGGL(mega_fwd, dim3(grid_blocks), dim3(512), LDS_BYTES, stream, p); }
#else
    p.lo = 0; p.hi = N_PHASES;
    void* args[] = {&p};
    hipError_t e = hipLaunchCooperativeKernel((const void*)mega_fwd, dim3(grid_blocks), dim3(512), args, LDS_BYTES, stream);
    if (e != hipSuccess) fprintf(stderr, "cooperative launch failed: %s (grid %d)\n", hipGetErrorString(e), grid_blocks);
#endif
}
```

```cpp
#include <hip/hip_runtime.h>
#include <hip/hip_cooperative_groups.h>
#include <cstdio>
#include <cstdint>
namespace cg = cooperative_groups;
namespace pg8 {
#define PG8_LAS __attribute__((address_space(3)))
typedef unsigned short bf16_t;
typedef short bf16x8 __attribute__((ext_vector_type(8)));
typedef float f32x4 __attribute__((ext_vector_type(4)));
typedef unsigned u32x4 __attribute__((ext_vector_type(4)));
constexpr int BM = 256, BK = 64, HALF = 128, HTB = HALF * BK * 2  , STAGE_BYTES = 8 * HTB, NXCD = 8, WGM = 8;

__host__ __device__ __forceinline__ int lds_byte(int r, int c) { const int st = (r >> 4) * 2 + (c >> 5), rr = r & 15, cc = c & 31, ob = rr * 64 + cc * 2; return st * 1024 + (ob ^ (((ob >> 9) & 1) << 5)); }
__host__ __device__ __forceinline__ void stage_rc(int b, int& R, int& C) { const int st = b / 1024, sb = b % 1024, swz = sb ^ (((sb >> 9) & 1) << 5); R = (st >> 1) * 16 + swz / 64; C = (st & 1) * 32 + (swz % 64) / 2; }
__host__ __device__ __forceinline__ int perm32(int rho) { const int n = rho >> 4, i = rho & 15; return 8 * (i >> 2) + 4 * n + (i & 3); }

struct Unit { int pm, pn; };
struct Gemm { const bf16_t* A; const bf16_t* Bt; int M, N, K; };

struct StaticOrder {
    int nM, nN, nwg, G, c;
    __host__ __device__ void init(int M, int N, int G_, int c_) { nM = M / BM; nN = N / BM; nwg = nM * nN; G = G_; c = c_; }
    __host__ __device__ bool next(int i, Unit& u) const {
        const long L = (long)i * G + c; if (L >= nwg) return false;
        int wgid = (int)L; { const int q = nwg / NXCD, r = nwg % NXCD, xcd = wgid % NXCD, off = wgid / NXCD; wgid = (xcd < r ? xcd * (q + 1) : r * (q + 1) + (xcd - r) * q) + off; }
        const int nig = WGM * nN, gid = wgid / nig, fm = gid * WGM, gsz = (nM - fm) < WGM ? (nM - fm) : WGM;
        u.pm = fm + ((wgid % nig) % gsz); u.pn = (wgid % nig) / gsz; return true;
    }
    __device__ __forceinline__ void a_ready(const Unit&) const {}
    __device__ __forceinline__ void done(const Unit&) const {}
};
__device__ __forceinline__ unsigned cvt_pk_bf16(float lo, float hi) { unsigned r; asm volatile("v_cvt_pk_bf16_f32 %0, %1, %2" : "=v"(r) : "v"(lo), "v"(hi)); return r; }
template <class Epi, class Sched, bool STAMP = false>
__device__ __forceinline__ void gemm_phase(PG8_LAS unsigned char* lds, const Gemm g, const Sched& S, const Epi& E, unsigned long long* stamps) {
    int tid_l = threadIdx.x; asm volatile("" : "+v"(tid_l));
    const int tid = tid_l, wid = __builtin_amdgcn_readfirstlane(tid >> 6), lane = tid & 63, wr = wid >> 2, wc = wid & 3, fr = lane & 15, fq = lane >> 4;
    const int K = g.K, nt = K / BK;
    int ts_lo = 0, ts_hi = 0, nts = 0; const unsigned long long rt_entry = STAMP ? (unsigned long long)wall_clock64() : 0ull;
#define PG8_STAMP() do { if (STAMP && wid == 0 && nts < 64) { const unsigned long long _c = (unsigned long long)clock64(); \
        ts_lo = (lane == nts) ? (int)(unsigned)_c : ts_lo; ts_hi = (lane == nts) ? (int)(unsigned)(_c >> 32) : ts_hi; ++nts; } } while (0)
    PG8_STAMP();
    unsigned voffA[2], voffB[2];
#pragma unroll
    for (int i = 0; i < 2; ++i) { int R, C; stage_rc(tid * 16 + i * 8192, R, C); const int Rb = Epi::PERM ? ((R & ~31) + perm32(R & 31)) : R;
        voffA[i] = (unsigned)(R * K + C) * 2u; voffB[i] = (unsigned)(Rb * K + C) * 2u; }
    const size_t kstep = (size_t)(BK * 2);
    const size_t hstep = (size_t)HALF * K * 2;
    const size_t tstep = 2 * hstep;
    const unsigned ldsw = (unsigned)wid * 1024u;
    const int aoff = lds_byte(wr * 64 + fr, fq * 8), boff = lds_byte(wc * 32 + fr, fq * 8);
#define PG8_SA(b, h) (((b) * 2 + (h)) * HTB)
#define PG8_SB(b, h) ((4 + (b) * 2 + (h)) * HTB)
#define PG8_STAGE(bufoff, gbase, voff) do { _Pragma("unroll") for (int _i = 0; _i < 2; ++_i) \
        __builtin_amdgcn_global_load_lds((const unsigned*)((const char*)(gbase) + (voff)[_i]), (PG8_LAS unsigned*)(lds + (bufoff) + ldsw + _i * 8192), 16, 0, 0); } while (0)
#define PG8_LDA(dst, b, h) do { _Pragma("unroll") for (int m = 0; m < 4; ++m) _Pragma("unroll") for (int k = 0; k < 2; ++k) dst[m][k] = *(const PG8_LAS bf16x8*)(lds + PG8_SA(b, h) + aoff + m * 2048 + k * 1024); } while (0)
#define PG8_LDB(dst, b, h) do { _Pragma("unroll") for (int n = 0; n < 2; ++n) _Pragma("unroll") for (int k = 0; k < 2; ++k) dst[n][k] = *(const PG8_LAS bf16x8*)(lds + PG8_SB(b, h) + boff + n * 2048 + k * 1024); } while (0)
#define PG8_MMA(ai, bj, At, Bt) do { __builtin_amdgcn_s_setprio(1); _Pragma("unroll") for (int m = 0; m < 4; ++m) _Pragma("unroll") for (int n = 0; n < 2; ++n) _Pragma("unroll") for (int k = 0; k < 2; ++k) \
        acc[ai][bj][m][n] = __builtin_amdgcn_mfma_f32_16x16x32_bf16(Bt[n][k], At[m][k], acc[ai][bj][m][n], 0, 0, 0); __builtin_amdgcn_s_setprio(0); } while (0)
#define PG8_WAIT_V(n) asm volatile("s_waitcnt vmcnt(" #n ")" ::: "memory")
#define PG8_WAIT_L(n) asm volatile("s_waitcnt lgkmcnt(" #n ")" ::: "memory")
#define PG8_BAR __builtin_amdgcn_s_barrier()
#define PG8_SCHED __builtin_amdgcn_sched_barrier(0)
    Unit cur, nxt; int ui = 0;
    if (!S.next(0, cur)) return;
    f32x4 acc[2][2][4][2];
#pragma unroll
    for (int a = 0; a < 2; ++a)
#pragma unroll
        for (int b = 0; b < 2; ++b)
#pragma unroll
            for (int m = 0; m < 4; ++m)
#pragma unroll
                for (int n = 0; n < 2; ++n) acc[a][b][m][n] = (f32x4){0.f, 0.f, 0.f, 0.f};
    bf16x8 At[4][2], B0[2][2], B1[2][2];
    const char* cA = (const char*)g.A + (size_t)cur.pm * tstep; const char* cB = (const char*)g.Bt + (size_t)cur.pn * tstep;
    S.a_ready(cur);
    PG8_STAGE(PG8_SB(0, 0), cB, voffB); PG8_STAGE(PG8_SA(0, 0), cA, voffA); PG8_STAGE(PG8_SB(0, 1), cB + hstep, voffB); PG8_STAGE(PG8_SA(0, 1), cA + hstep, voffA);
    if (wr == 1) PG8_BAR;
    PG8_WAIT_V(4); PG8_BAR;
    PG8_STAGE(PG8_SB(1, 0), cB + kstep, voffB); PG8_STAGE(PG8_SA(1, 0), cA + kstep, voffA); PG8_STAGE(PG8_SB(1, 1), cB + hstep + kstep, voffB);
    PG8_WAIT_V(6); PG8_BAR;
    PG8_STAMP();
    for (;;) {
        const bool has_next = S.next(ui + 1, nxt);
        const char* nA = has_next ? (const char*)g.A + (size_t)nxt.pm * tstep : cA; const char* nB = has_next ? (const char*)g.Bt + (size_t)nxt.pn * tstep : cB;
        for (int t = 0; t < nt; t += 2) {
            const bool last = (t == nt - 2);
            const char* a1 = cA + (size_t)(t + 1) * kstep;
            const char* a2 = last ? nA : cA + (size_t)(t + 2) * kstep; const char* b2 = last ? nB : cB + (size_t)(t + 2) * kstep;
            const char* a3 = a2 + kstep; const char* b3 = b2 + kstep;
            if (last && has_next) S.a_ready(nxt);
            PG8_LDB(B0, 0, 0); PG8_SCHED; PG8_LDA(At, 0, 0); PG8_STAGE(PG8_SA(1, 1), a1 + hstep, voffA);
            PG8_WAIT_L(8); PG8_BAR; PG8_WAIT_L(0); PG8_MMA(0, 0, At, B0); PG8_BAR; PG8_SCHED;
            PG8_LDB(B1, 0, 1); PG8_STAGE(PG8_SB(0, 0), b2, voffB);
            PG8_BAR; PG8_WAIT_L(0); PG8_MMA(0, 1, At, B1); PG8_BAR;
            PG8_LDA(At, 0, 1); PG8_STAGE(PG8_SA(0, 0), a2, voffA);
            PG8_BAR; PG8_WAIT_L(0); PG8_MMA(1, 0, At, B0); PG8_BAR; PG8_SCHED;
            PG8_STAGE(PG8_SB(0, 1), b2 + hstep, voffB);
            PG8_WAIT_V(6); PG8_BAR; PG8_MMA(1, 1, At, B1); PG8_BAR;
            PG8_LDB(B0, 1, 0); PG8_SCHED; PG8_LDA(At, 1, 0); PG8_STAGE(PG8_SA(0, 1), a2 + hstep, voffA);
            PG8_WAIT_L(8); PG8_BAR; PG8_WAIT_L(0); PG8_MMA(0, 0, At, B0); PG8_BAR; PG8_SCHED;
            PG8_LDB(B1, 1, 1); PG8_STAGE(PG8_SB(1, 0), b3, voffB);
            PG8_BAR; PG8_WAIT_L(0); PG8_MMA(0, 1, At, B1); PG8_BAR;
            PG8_LDA(At, 1, 1); PG8_STAGE(PG8_SA(1, 0), a3, voffA);
            PG8_BAR; PG8_WAIT_L(0); PG8_MMA(1, 0, At, B0); PG8_BAR; PG8_SCHED;
            PG8_STAGE(PG8_SB(1, 1), b3 + hstep, voffB);
            PG8_WAIT_V(6); PG8_BAR; PG8_MMA(1, 1, At, B1); PG8_BAR;
        }
        PG8_STAMP();
        if constexpr (!Epi::AFTER_DRAIN) { E(acc, cur, wr, wc, fr, fq); S.done(cur); }
        PG8_STAMP();
        if (!has_next) break;
#pragma unroll
        for (int a = 0; a < 2; ++a)
#pragma unroll
            for (int b = 0; b < 2; ++b)
#pragma unroll
                for (int m = 0; m < 4; ++m)
#pragma unroll
                    for (int n = 0; n < 2; ++n) acc[a][b][m][n] = (f32x4){0.f, 0.f, 0.f, 0.f};
        cur = nxt; cA = nA; cB = nB; ++ui;
    }
    PG8_WAIT_V(0);
    if (wr == 0) PG8_BAR;
    PG8_BAR;
    if constexpr (Epi::AFTER_DRAIN) { E.fused(acc, cur, wr, wc, fr, fq, lds, wid, lane); S.done(cur); }
    PG8_STAMP();
    if (STAMP && wid == 0) { stamps[lane] = lane < nts ? (((unsigned long long)(unsigned)ts_hi << 32) | (unsigned)ts_lo) : 0ull;
        if (lane == 62) stamps[62] = rt_entry; if (lane == 63) stamps[63] = (unsigned long long)wall_clock64(); }
#undef PG8_STAMP
#undef PG8_SA
#undef PG8_SB
#undef PG8_STAGE
#undef PG8_LDA
#undef PG8_LDB
#undef PG8_MMA
#undef PG8_WAIT_V
#undef PG8_WAIT_L
#undef PG8_BAR
#undef PG8_SCHED
}
}
#define LAS __attribute__((address_space(3)))
typedef unsigned short bf16_t;
typedef short bf16x8 __attribute__((ext_vector_type(8)));
typedef float f32x4 __attribute__((ext_vector_type(4)));
typedef unsigned u32x4 __attribute__((ext_vector_type(4)));
typedef unsigned u32x2 __attribute__((ext_vector_type(2)));
typedef unsigned long long u64;

#ifndef MULTI_LAUNCH
#define MULTI_LAUNCH 0
#endif

constexpr int T_TOK = 65536, SEQ = 2048, NBATCH = 32, DM = 1024, NP = 3584, INW = 3540;
constexpr int C_Q = 0, C_K = 384, C_V = 768, C_AZ = 1152, C_IQ = 1536, C_IK = 1792, C_IW = 1856, C_GGR = 1864, C_PU = 1920, C_PZ = 2176,
              C_GQ = 2432, C_GK = 2624, C_GV = 2816, C_GZ = 3200;
constexpr int LDS_BYTES = 150528;
constexpr int LDS_HIST = 131328;
constexpr int LDS_QUEUE = 149760;
constexpr int LDS_XBST = 149824;
constexpr int LDS_PROF = 149888;
constexpr int CW_BAR = 1024;
constexpr int CTL_BYTES = 32768;
constexpr size_t MiB = 1u << 20;
constexpr size_t WS_CTL = 0, WS_WIN = 1 * MiB, WS_WOUT = 16 * MiB, WS_RINV = 20 * MiB, WS_MASK = 24 * MiB, WS_XB = 40 * MiB,
                 WS_MIX = 168 * MiB, WS_PROJ = 296 * MiB, WS_VT = 776 * MiB, WS_END = 824 * MiB;
constexpr int N_PHASES = 10;
constexpr float LOG2E = 1.4426950408889634f;

struct Params {
    const float* x; const float* norm_g; const float* w_in; const float* qg; const float* kg; const float* pool_w; const float* pool_scale;
    const float* wgate; const float* bgate; const float* ogain; const float* w_out; float* out; unsigned char* ws; int lo, hi;
};

__device__ __forceinline__ float bf_lo(unsigned w) { return __uint_as_float(w << 16); }
__device__ __forceinline__ float bf_hi(unsigned w) { return __uint_as_float(w & 0xffff0000u); }
__device__ __forceinline__ unsigned pk2(float lo, float hi) { return pg8::cvt_pk_bf16(lo, hi); }
__device__ __forceinline__ void unpack8(const u32x4 w, float (&f)[8]) {
    f[0] = bf_lo(w.x); f[1] = bf_hi(w.x); f[2] = bf_lo(w.y); f[3] = bf_hi(w.y); f[4] = bf_lo(w.z); f[5] = bf_hi(w.z); f[6] = bf_lo(w.w); f[7] = bf_hi(w.w);
}
__device__ __forceinline__ u32x4 pack8(const float (&f)[8]) { u32x4 w; w.x = pk2(f[0], f[1]); w.y = pk2(f[2], f[3]); w.z = pk2(f[4], f[5]); w.w = pk2(f[6], f[7]); return w; }
__device__ __forceinline__ f32x4 mfma16(bf16x8 a, bf16x8 b, f32x4 c) { return __builtin_amdgcn_mfma_f32_16x16x32_bf16(a, b, c, 0, 0, 0); }
__device__ __forceinline__ bf16x8 as_bf8(u32x4 w) { return __builtin_bit_cast(bf16x8, w); }
__device__ __forceinline__ float silu_f(float z) { return z * __builtin_amdgcn_rcpf(1.0f + __expf(-z)); }
__device__ __forceinline__ float wave_sum(float v) {
#pragma unroll
    for (int o = 1; o < 64; o <<= 1) v += __shfl_xor(v, o);
    return v;
}
#define LDS_WAIT() asm volatile("s_waitcnt lgkmcnt(0)" ::: "memory")
#define LDS_BARRIER() do { asm volatile("s_waitcnt lgkmcnt(0)" ::: "memory"); __builtin_amdgcn_s_barrier(); asm volatile("" ::: "memory"); } while (0)
#ifdef PROBE_SEC
#define PROF_T(v) const unsigned long long v = clock64()
#define PROF_ACC(id, t0v, t1v) do { if ((id) == PROBE_SEC && threadIdx.x == 0 && blockIdx.x == PROBE_BLK) { volatile LAS unsigned long long* pr_ = (volatile LAS unsigned long long*)(lds + LDS_PROF); pr_[0] = pr_[0] + ((t1v) - (t0v)); } } while (0)
#else
#define PROF_T(v) do {} while (0)
#define PROF_ACC(id, t0v, t1v) do {} while (0)
#endif

struct EpiProj {
    static constexpr bool PERM = true, AFTER_DRAIN = false;
    bf16_t* O; const float* rinv;
    __device__ __forceinline__ void operator()(const pg8::f32x4 (&acc)[2][2][4][2], const pg8::Unit& u, int wr, int wc, int fr, int fq) const {
        const int row0 = u.pm * 256 + wr * 64 + fr, col0 = u.pn * 256 + wc * 32 + 8 * fq;
        asm volatile("" ::: "memory");
        float rs[2][4];
#pragma unroll
        for (int ai = 0; ai < 2; ++ai)
#pragma unroll
            for (int m = 0; m < 4; ++m) rs[ai][m] = rinv[row0 + ai * 128 + m * 16];
#pragma unroll
        for (int ai = 0; ai < 2; ++ai)
#pragma unroll
            for (int m = 0; m < 4; ++m) {
                const int row = row0 + ai * 128 + m * 16; const float rsv = rs[ai][m];
                bf16_t* rowp = O + (size_t)row * NP + col0;
#pragma unroll
                for (int bj = 0; bj < 2; ++bj) {
                    const pg8::f32x4 v0 = acc[ai][bj][m][0] * rsv, v1 = acc[ai][bj][m][1] * rsv;
                    u32x4 w; w.x = pk2(v0[0], v0[1]); w.y = pk2(v0[2], v0[3]); w.z = pk2(v1[0], v1[1]); w.w = pk2(v1[2], v1[3]);
                    *(u32x4*)(rowp + bj * 128) = w;
                }
            }
    }
};
struct EpiOut0 {
    static constexpr bool PERM = false, AFTER_DRAIN = false;
    bf16_t* xb;
    __device__ __forceinline__ void operator()(const pg8::f32x4 (&acc)[2][2][4][2], const pg8::Unit& u, int wr, int wc, int fr, int fq) const {
        const int row0 = u.pm * 256 + wr * 64 + fr, col0 = u.pn * 256 + wc * 32 + 4 * fq;
#pragma unroll
        for (int ai = 0; ai < 2; ++ai)
#pragma unroll
            for (int m = 0; m < 4; ++m) {
                if (m == 0) asm volatile("" ::: "memory");
                const size_t off = (size_t)(row0 + ai * 128 + m * 16) * DM + col0;
#pragma unroll
                for (int bj = 0; bj < 2; ++bj)
#pragma unroll
                    for (int n = 0; n < 2; ++n) {
                        const u32x2 xw = *(const u32x2*)(xb + off + bj * 128 + n * 16);
                        pg8::f32x4 v; v[0] = bf_lo(xw.x); v[1] = bf_hi(xw.x); v[2] = bf_lo(xw.y); v[3] = bf_hi(xw.y);
                        v = v + acc[ai][bj][m][n];
                        u32x2 w; w.x = pk2(v[0], v[1]); w.y = pk2(v[2], v[3]); *(u32x2*)(xb + off + bj * 128 + n * 16) = w;
                    }
            }
    }
};
struct EpiOut1 {
    static constexpr bool PERM = false, AFTER_DRAIN = false;
    const bf16_t* xb; float* out;
    __device__ __forceinline__ void operator()(const pg8::f32x4 (&acc)[2][2][4][2], const pg8::Unit& u, int wr, int wc, int fr, int fq) const {
        const int row0 = u.pm * 256 + wr * 64 + fr, col0 = u.pn * 256 + wc * 32 + 4 * fq;
#pragma unroll
        for (int ai = 0; ai < 2; ++ai)
#pragma unroll
            for (int m = 0; m < 4; ++m) {
                if (m == 0) asm volatile("" ::: "memory");
                const size_t off = (size_t)(row0 + ai * 128 + m * 16) * DM + col0;
#pragma unroll
                for (int bj = 0; bj < 2; ++bj)
#pragma unroll
                    for (int n = 0; n < 2; ++n) {
                        const u32x2 w = *(const u32x2*)(xb + off + bj * 128 + n * 16);
                        pg8::f32x4 v; v[0] = bf_lo(w.x); v[1] = bf_hi(w.x); v[2] = bf_lo(w.y); v[3] = bf_hi(w.y);
                        *(pg8::f32x4*)(out + off + bj * 128 + n * 16) = v + acc[ai][bj][m][n];
                    }
            }
    }
};

__device__ __forceinline__ float win_eff(const Params& p, int l, int k, int n) {
    const float* W = p.w_in + ((size_t)l * DM + k) * INW;
    if (n < 1860) return W[n];
    if (n < C_PU) return (n >= C_GGR && n < C_GGR + 16) ? W[3140 + (n - C_GGR)] : 0.f;
    if (n < C_PZ) {
        const int gi = (n - C_PU) >> 6, d = (n - C_PU) & 63;
        const float* pw = p.pool_w + ((size_t)(l * 4 + gi) * 64) * 64 + d; const float* wr = W + 1860 + gi * 64; float s = 0.f;
        for (int c = 0; c < 64; ++c) s += wr[c] * pw[c * 64];
        return s * p.pool_scale[l * 256 + gi * 64 + d];
    }
    if (n < C_GQ) return W[2116 + (n - C_PZ)];
    if (n < C_GK) return W[2372 + (n - C_GQ)];
    if (n < C_GV) return W[2564 + (n - C_GK)];
    if (n < C_GZ) return W[2756 + (n - C_GV)];
    return W[3156 + (n - C_GZ)];
}

__device__ __forceinline__ void phase_weights(const Params& p, LAS unsigned char* lds, int gw, int ngw, int wave, int lane) {
    LAS float* scr = (LAS float*)(lds + wave * 8704);
    bf16_t* WIN = (bf16_t*)(p.ws + WS_WIN); bf16_t* WOUT = (bf16_t*)(p.ws + WS_WOUT);
    constexpr int NI_IN = 2 * 16 * 112, NI_OUT = 2 * 16 * 32;
    for (int it = gw; it < NI_IN + NI_OUT; it += ngw) {
        const int nn = lane & 31;
        bf16_t* dst; int k0, n0, ldk = DM;
        if (it < NI_IN) {
            const int l = it / 1792, r = it % 1792, kb = r / 112, nb = r % 112; k0 = 64 * kb; n0 = 32 * nb;
            if (n0 >= C_PU && n0 < C_PZ) {
                const int gi = (n0 - C_PU) >> 6, d = ((n0 - C_PU) & 63) + nn;
                const float* pw = p.pool_w + ((size_t)(l * 4 + gi) * 64) * 64 + d; const float scl = p.pool_scale[l * 256 + gi * 64 + d];
                float pwr[64];
#pragma unroll
                for (int c = 0; c < 64; ++c) pwr[c] = pw[c * 64] * scl;
#pragma unroll 2
                for (int i = 0; i < 32; ++i) {
                    const int kk = 2 * i + (lane >> 5), k = k0 + kk;
                    const f32x4* wr = (const f32x4*)(p.w_in + ((size_t)l * DM + k) * INW + 1860 + gi * 64);
                    float sa = 0.f, sb = 0.f;
#pragma unroll
                    for (int c4 = 0; c4 < 16; c4 += 2) { const f32x4 w0 = wr[c4], w1 = wr[c4 + 1];
                        sa += (w0.x * pwr[4 * c4] + w0.y * pwr[4 * c4 + 1]) + (w0.z * pwr[4 * c4 + 2] + w0.w * pwr[4 * c4 + 3]);
                        sb += (w1.x * pwr[4 * c4 + 4] + w1.y * pwr[4 * c4 + 5]) + (w1.z * pwr[4 * c4 + 6] + w1.w * pwr[4 * c4 + 7]); }
                    scr[kk * 33 + nn] = (sa + sb) * p.norm_g[l * DM + k];
                }
            } else {
#pragma unroll 4
                for (int i = 0; i < 32; ++i) { const int kk = 2 * i + (lane >> 5), k = k0 + kk; scr[kk * 33 + nn] = win_eff(p, l, k, n0 + nn) * p.norm_g[l * DM + k]; }
            }
            dst = WIN + (size_t)l * NP * DM;
        } else {
            const int r0 = it - NI_IN, l = r0 / 512, r = r0 % 512, kb = r / 32, nb = r % 32; k0 = 64 * kb; n0 = 32 * nb;
            const float* W = p.w_out + (size_t)l * DM * DM;
#pragma unroll 4
            for (int i = 0; i < 32; ++i) { const int kk = 2 * i + (lane >> 5), k = k0 + kk; scr[kk * 33 + nn] = W[(size_t)k * DM + n0 + nn]; }
            dst = WOUT + (size_t)l * DM * DM;
        }
        LDS_WAIT();
        const int c = lane & 7;
#pragma unroll
        for (int j = 0; j < 4; ++j) {
            const int n = (lane >> 3) + 8 * j; const LAS float* s = scr + (8 * c) * 33 + n;
            u32x4 o; o.x = pk2(s[0 * 33], s[1 * 33]); o.y = pk2(s[2 * 33], s[3 * 33]); o.z = pk2(s[4 * 33], s[5 * 33]); o.w = pk2(s[6 * 33], s[7 * 33]);
            *(u32x4*)(dst + (size_t)(n0 + n) * ldk + k0 + 8 * c) = o;
        }
        LDS_WAIT();
    }
}
__device__ __forceinline__ void phase_prep_x(const Params& p, const float* src, int gw, int ngw, int lane) {
    bf16_t* xb = (bf16_t*)(p.ws + WS_XB); float* rinv = (float*)(p.ws + WS_RINV);
    for (int m0 = gw * 4; m0 < T_TOK; m0 += ngw * 4) {
        f32x4 v[4][4]; float s[4];
#pragma unroll
        for (int r = 0; r < 4; ++r) { const f32x4* xr = (const f32x4*)(src + (size_t)(m0 + r) * DM) + lane;
#pragma unroll
            for (int j = 0; j < 4; ++j) v[r][j] = xr[64 * j]; }
#pragma unroll
        for (int r = 0; r < 4; ++r) { float a = 0.f;
#pragma unroll
            for (int j = 0; j < 4; ++j) a += (v[r][j].x * v[r][j].x + v[r][j].y * v[r][j].y) + (v[r][j].z * v[r][j].z + v[r][j].w * v[r][j].w);
            s[r] = wave_sum(a); }
#pragma unroll
        for (int r = 0; r < 4; ++r) {
            if (lane == 0) rinv[m0 + r] = __builtin_amdgcn_rsqf(s[r] * (1.0f / DM) + 1e-6f);
            u32x2* o8 = (u32x2*)(xb + (size_t)(m0 + r) * DM) + lane;
#pragma unroll
            for (int j = 0; j < 4; ++j) { u32x2 w; w.x = pk2(v[r][j].x, v[r][j].y); w.y = pk2(v[r][j].z, v[r][j].w); o8[64 * j] = w; }
        }
    }
}

__device__ __forceinline__ void phase_rinv_bf16(const Params& p, int gw, int ngw, int lane) {
    const bf16_t* xb = (const bf16_t*)(p.ws + WS_XB); float* rinv = (float*)(p.ws + WS_RINV);
    for (int m0 = gw * 8; m0 < T_TOK; m0 += ngw * 8) {
        u32x4 v[8][2];
#pragma unroll
        for (int r = 0; r < 8; ++r) { const u32x4* xr = (const u32x4*)(xb + (size_t)(m0 + r) * DM) + lane; v[r][0] = xr[0]; v[r][1] = xr[64]; }
#pragma unroll
        for (int r = 0; r < 8; ++r) {
            float f[8], a = 0.f;
            unpack8(v[r][0], f);
#pragma unroll
            for (int k = 0; k < 8; ++k) a += f[k] * f[k];
            unpack8(v[r][1], f);
#pragma unroll
            for (int k = 0; k < 8; ++k) a += f[k] * f[k];
            a = wave_sum(a);
            if (lane == 0) rinv[m0 + r] = __builtin_amdgcn_rsqf(a * (1.0f / DM) + 1e-6f);
        }
    }
}

__device__ __forceinline__ void qknorm_item(const Params& p, int l, int item, int tid, LAS unsigned char* lds) {
    bf16_t* proj = (bf16_t*)(p.ws + WS_PROJ);
    {
        LAS bf16_t* tv = (LAS bf16_t*)lds;
        bf16_t* vT = (bf16_t*)(p.ws + WS_VT);
        const size_t row0 = (size_t)item * 64; const int b = (int)(row0 >> 11), t0 = (int)(row0 & (SEQ - 1));
#pragma unroll
        for (int i = 0; i < 6; ++i) { const int id = tid + 512 * i, r = id / 48, c8 = id % 48; *(LAS u32x4*)(tv + r * 392 + c8 * 8) = *(const u32x4*)(proj + (row0 + r) * NP + C_V + c8 * 8); }
        LDS_BARRIER();
#pragma unroll
        for (int i = 0; i < 6; ++i) {
            const int id = tid + 512 * i, tc = id / 384, hd = id % 384;
            const LAS bf16_t* src = tv + (8 * tc) * 392 + hd;
            u32x4 w; w.x = (unsigned)src[0] | ((unsigned)src[392] << 16); w.y = (unsigned)src[2 * 392] | ((unsigned)src[3 * 392] << 16);
            w.z = (unsigned)src[4 * 392] | ((unsigned)src[5 * 392] << 16); w.w = (unsigned)src[6 * 392] | ((unsigned)src[7 * 392] << 16);
            *(u32x4*)(vT + ((size_t)b * 384 + hd) * SEQ + t0 + 8 * tc) = w;
        }
    }
    {
        u32x4 wv[12];
#pragma unroll
        for (int i = 0; i < 12; ++i) { const int idx = tid + 512 * i, r = idx / 96, ch = idx % 96; wv[i] = *(const u32x4*)(proj + ((size_t)item * 64 + r) * NP + ch * 8); }
#pragma unroll
        for (int i = 0; i < 12; ++i) {
            const int idx = tid + 512 * i, ch = idx % 96;
            float f[8]; unpack8(wv[i], f);
            float ss = 0.f;
#pragma unroll
            for (int k = 0; k < 8; ++k) ss += f[k] * f[k];
            ss += __shfl_xor(ss, 1); ss += __shfl_xor(ss, 2); ss += __shfl_xor(ss, 4);
            const float rn = __builtin_amdgcn_rsqf(ss * (1.0f / 64.0f) + 1e-6f);
            const bool isq = ch < 48; const float* gp = (isq ? p.qg : p.kg) + l * 64 + (ch & 7) * 8; const float sc = isq ? (0.125f * LOG2E) * rn : rn;
#pragma unroll
            for (int k = 0; k < 8; ++k) f[k] = f[k] * sc * gp[k];
            wv[i] = pack8(f);
        }
#pragma unroll
        for (int i = 0; i < 12; ++i) { const int idx = tid + 512 * i, r = idx / 96, ch = idx % 96; *(u32x4*)(proj + ((size_t)item * 64 + r) * NP + ch * 8) = wv[i]; }
    }
}
__device__ __forceinline__ void pool_item(const Params& p, int item, int tid) {
    const bf16_t* proj = (const bf16_t*)(p.ws + WS_PROJ); bf16_t* mix = (bf16_t*)(p.ws + WS_MIX);
    const int ch = tid & 31, rb = tid >> 5; const size_t R0 = (size_t)item * 256 + rb * 16; const int t0r = (int)(R0 & (SEQ - 1));
    const int w = 2 << (ch >> 3);
    const bf16_t* up = proj + R0 * NP + C_PU + ch * 8; const bf16_t* zp = proj + R0 * NP + C_PZ + ch * 8;
    float acc[8], f[8], g[8];
#pragma unroll
    for (int k = 0; k < 8; ++k) acc[k] = 0.f;
    for (int j = 1; j < w; ++j) if (t0r - j >= 0) { unpack8(*(const u32x4*)(up - (size_t)j * NP), f);
#pragma unroll
        for (int k = 0; k < 8; ++k) acc[k] += f[k]; }
    u32x4 outv[16];
#pragma unroll
    for (int i = 0; i < 16; ++i) {
        const int t = t0r + i;
        unpack8(*(const u32x4*)(up + (size_t)i * NP), f);
#pragma unroll
        for (int k = 0; k < 8; ++k) acc[k] += f[k];
        const int cnt = (t + 1 < w) ? (t + 1) : w; const float ic = __builtin_amdgcn_rcpf((float)cnt);
        unpack8(*(const u32x4*)(zp + (size_t)i * NP), g);
#pragma unroll
        for (int k = 0; k < 8; ++k) g[k] = (acc[k] * ic - f[k]) * silu_f(g[k]);
        outv[i] = pack8(g);
        if (t - w + 1 >= 0) { unpack8(*(const u32x4*)(up + ((ptrdiff_t)i - (w - 1)) * NP), f);
#pragma unroll
            for (int k = 0; k < 8; ++k) acc[k] -= f[k]; }
    }
#pragma unroll
    for (int i = 0; i < 16; ++i) *(u32x4*)(mix + (R0 + i) * DM + 384 + ch * 8) = outv[i];
}

__device__ __forceinline__ unsigned f2ord(float f) { const unsigned b = __float_as_uint(f); return b ^ ((b >> 31) ? 0xFFFFFFFFu : 0x80000000u); }
__device__ __forceinline__ void hist_find(const LAS unsigned* hist, int lane, int R, int& B, int& cab, int& nB) {
    const u32x4 a = ((const LAS u32x4*)hist)[2 * lane], b = ((const LAS u32x4*)hist)[2 * lane + 1];
    const unsigned h[8] = {a.x, a.y, a.z, a.w, b.x, b.y, b.z, b.w};
    const unsigned s8 = (h[0] + h[1]) + (h[2] + h[3]) + (h[4] + h[5]) + (h[6] + h[7]);
    unsigned v = s8;
#pragma unroll
    for (int off = 1; off < 64; off <<= 1) { const unsigned tt = (unsigned)__shfl_down((int)v, off); v += (lane + off < 64) ? tt : 0u; }
    const int sx = (int)(v - s8);
    const bool mine = (sx < R) && (R <= (int)v);
    int c = sx, Bk = 0, cabk = 0, nk = 0; bool found = false;
#pragma unroll
    for (int k = 7; k >= 0; --k) { if (!found && c + (int)h[k] >= R) { Bk = 8 * lane + k; cabk = c; nk = (int)h[k]; found = true; } c += (int)h[k]; }
    const u64 mm = __ballot(mine); const int src = mm ? (__ffsll((long long)mm) - 1) : 0;
    B = __builtin_amdgcn_readfirstlane(__shfl(Bk, src)); cab = __builtin_amdgcn_readfirstlane(__shfl(cabk, src)); nB = __builtin_amdgcn_readfirstlane(__shfl(nk, src));
}
template <int NJ>
__device__ __forceinline__ u64 select_row(const LAS float* srow, int t, int lane, LAS unsigned* hist) {
    float f[NJ]; int k18[NJ]; float fmx = -INFINITY, fmn = INFINITY;
#pragma unroll
    for (int j = 0; j < NJ; ++j) {
        const int key = j * 64 + lane; const float v = srow[key]; const bool valid = key <= t;
        f[j] = v; k18[j] = valid ? 0 : -1; fmx = fmaxf(fmx, valid ? v : -INFINITY); fmn = fminf(fmn, valid ? v : INFINITY);
    }
#pragma unroll
    for (int off = 32; off; off >>= 1) { fmx = fmaxf(fmx, __shfl_xor(fmx, off)); fmn = fminf(fmn, __shfl_xor(fmn, off)); }
    const float lo_f = __uint_as_float((unsigned)__builtin_amdgcn_readfirstlane((int)__float_as_uint(fmn)));
    const float hi_f = __uint_as_float((unsigned)__builtin_amdgcn_readfirstlane((int)__float_as_uint(fmx)));
    u64 myword = 0ull; bool fast = false;
    if (hi_f > lo_f) {
        const float sc18 = 262143.0f / (hi_f - lo_f);
        ((LAS u32x4*)hist)[2 * lane] = (u32x4){0u, 0u, 0u, 0u}; ((LAS u32x4*)hist)[2 * lane + 1] = (u32x4){0u, 0u, 0u, 0u};
        LDS_WAIT();
#pragma unroll
        for (int j = 0; j < NJ; ++j) {
            const bool valid = k18[j] >= 0; const unsigned kk = min((unsigned)((f[j] - lo_f) * sc18), 262143u);
            k18[j] = valid ? (int)kk : -1;
            __hip_atomic_fetch_add(hist + (valid ? (kk >> 9) : (unsigned)(512 + lane)), 1u, __ATOMIC_RELAXED, __HIP_MEMORY_SCOPE_WORKGROUP);
        }
        LDS_WAIT();
        int B1, cab1, n1; hist_find(hist, lane, 256, B1, cab1, n1);
        LDS_WAIT();
        ((LAS u32x4*)hist)[2 * lane] = (u32x4){0u, 0u, 0u, 0u}; ((LAS u32x4*)hist)[2 * lane + 1] = (u32x4){0u, 0u, 0u, 0u};
        LDS_WAIT();
#pragma unroll
        for (int j = 0; j < NJ; ++j) __hip_atomic_fetch_add(hist + (((k18[j] >> 9) == B1) ? (unsigned)(k18[j] & 511) : (unsigned)(512 + lane)), 1u, __ATOMIC_RELAXED, __HIP_MEMORY_SCOPE_WORKGROUP);
        LDS_WAIT();
        int B2, cab2, n2; hist_find(hist, lane, 256 - cab1, B2, cab2, n2);
        LDS_WAIT();
        const int kstar = (B1 << 9) | B2, rr = 256 - cab1 - cab2;
        if (rr == n2) {
            fast = true;
#pragma unroll
            for (int j = 0; j < NJ; ++j) { const u64 w = __ballot(k18[j] >= kstar); if (lane == j) myword = w; }
        } else {
            if (n2 > 8) {
                float bmin = INFINITY, bmax = -INFINITY;
#pragma unroll
                for (int j = 0; j < NJ; ++j) { const bool inb = (k18[j] == kstar); bmin = fminf(bmin, inb ? f[j] : INFINITY); bmax = fmaxf(bmax, inb ? f[j] : -INFINITY); }
#pragma unroll
                for (int off = 32; off; off >>= 1) { bmin = fminf(bmin, __shfl_xor(bmin, off)); bmax = fmaxf(bmax, __shfl_xor(bmax, off)); }
                if (__builtin_amdgcn_readfirstlane((int)(bmin == bmax))) {
                    fast = true; int need = rr;
#pragma unroll
                    for (int j = 0; j < NJ; ++j) {
                        u64 w = __ballot(k18[j] > kstar);
                        if (need > 0) {
                            u64 eq = __ballot(k18[j] == kstar); const int c = __popcll(eq);
                            if (c <= need) { w |= eq; need -= c; }
                            else { while (need > 0) { const u64 low = eq & (~eq + 1ull); w |= low; eq ^= low; --need; } }
                        }
                        if (lane == j) myword = w;
                    }
                }
            }
            if (!fast && n2 <= 64) {
                fast = true;
                int base = 0;
#pragma unroll
                for (int j = 0; j < NJ; ++j) {
                    const bool inb = (k18[j] == kstar); const u64 m = __ballot(inb);
                    if (m) {
                        if (inb) { const int pos = base + (int)__builtin_amdgcn_mbcnt_hi((unsigned)(m >> 32), __builtin_amdgcn_mbcnt_lo((unsigned)m, 0u)); hist[pos] = f2ord(f[j]); hist[64 + pos] = (unsigned)(j * 64 + lane); }
                        base += __popcll(m);
                    }
                }
                LDS_WAIT();
                const unsigned cu = (lane < n2) ? hist[lane] : 0u; const int ck = (lane < n2) ? (int)hist[64 + lane] : 0;
                LDS_WAIT();
                int rank = 0;
                for (int k = 0; k < n2; ++k) { const unsigned x = (unsigned)__builtin_amdgcn_readlane((int)cu, k); rank += (x > cu || (x == cu && k < lane)) ? 1 : 0; }
                const u64 selm = __ballot((lane < n2) && (rank < rr));
#pragma unroll
                for (int j = 0; j < NJ; ++j) { const u64 w = __ballot(k18[j] > kstar); if (lane == j) myword = w; }
                for (int k = 0; k < n2; ++k) if ((selm >> k) & 1ull) { const int key = __builtin_amdgcn_readlane(ck, k); if (lane == (key >> 6)) myword |= 1ull << (key & 63); }
            }
        }
    }
    if (!fast) {
        PROF_T(fb0);
#ifdef PROBE_SEC
        LAS unsigned char* lds = (LAS unsigned char*)hist - LDS_HIST;
#endif
        unsigned u[NJ]; unsigned umax = 0u;
#pragma unroll
        for (int j = 0; j < NJ; ++j) { u[j] = (k18[j] >= 0) ? f2ord(f[j]) : 0u; umax = max(umax, u[j]); }
#pragma unroll
        for (int off = 32; off; off >>= 1) umax = max(umax, (unsigned)__shfl_xor((int)umax, off));
        const unsigned hi_u = (unsigned)__builtin_amdgcn_readfirstlane((int)umax);
        unsigned prefix = 0u; int cge = t + 1;
        for (int bit = 31; bit >= 0; --bit) {
            const unsigned cand = prefix | (1u << bit);
            if (cand > hi_u) continue;
            int cnt = 0;
#pragma unroll
            for (int j = 0; j < NJ; ++j) cnt += __popcll(__ballot(u[j] >= cand));
            if (cnt >= 256) { prefix = cand; cge = cnt; }
            if (cnt == 256) break;
        }
        int cgt = 0;
#pragma unroll
        for (int j = 0; j < NJ; ++j) cgt += __popcll(__ballot(u[j] > prefix));
        int need = 256 - cgt;
#pragma unroll
        for (int j = 0; j < NJ; ++j) {
            u64 w = __ballot(u[j] > prefix); u64 eq = __ballot(u[j] == prefix); const int c = __popcll(eq);
            if (c <= need) { w |= eq; need -= c; }
            else { while (need > 0) { const u64 low = eq & (~eq + 1ull); w |= low; eq ^= low; --need; } }
            if (lane == j) myword = w;
        }
        PROF_T(fb1); PROF_ACC(11, fb0, fb1);
    }
    return myword;
}
__device__ __forceinline__ bool sel_item(const Params& p, int b, int qt, LAS unsigned char* lds, int tid, int wave, int lane, unsigned* ctr) {
    u64* mask = (u64*)(p.ws + WS_MASK);
    const int t0 = qt * 16;
    if (t0 < 256) {
        const int n = tid >> 5, j = tid & 31, t = t0 + n, lo = j * 64; u64 w;
        if (t >= lo + 63) w = ~0ull; else if (t < lo) w = 0ull; else w = (2ull << (t - lo)) - 1ull;
        mask[((size_t)b * SEQ + t) * 32 + j] = w;
        return false;
    }
    PROF_T(st0);
    const bf16_t* pb = (const bf16_t*)(p.ws + WS_PROJ) + (size_t)b * SEQ * NP;
    LAS float* sc = (LAS float*)lds;
    const int n = lane & 15, g = lane >> 4;
    {
        bf16x8 bq[4][2]; float iw[4];
        const bf16_t* qrow = pb + (size_t)(t0 + n) * NP;
#pragma unroll
        for (int h = 0; h < 4; ++h) {
#pragma unroll
            for (int ks = 0; ks < 2; ++ks) bq[h][ks] = as_bf8(*(const u32x4*)(qrow + C_IQ + h * 64 + ks * 32 + g * 8));
        }
        { const u32x2 w = *(const u32x2*)(qrow + C_IW); iw[0] = 0.5f * bf_lo(w.x); iw[1] = 0.5f * bf_hi(w.x); iw[2] = 0.5f * bf_lo(w.y); iw[3] = 0.5f * bf_hi(w.y); }
        const int nkt = qt + 1;
        for (int kt = wave; kt < nkt; kt += 8) {
            const bf16_t* krow = pb + (size_t)(kt * 16 + n) * NP + C_IK + g * 8;
            const bf16x8 a0 = as_bf8(*(const u32x4*)krow), a1 = as_bf8(*(const u32x4*)(krow + 32));
            f32x4 s = {0.f, 0.f, 0.f, 0.f};
#pragma unroll
            for (int h = 0; h < 4; ++h) {
                f32x4 c = {0.f, 0.f, 0.f, 0.f};
                c = mfma16(a0, bq[h][0], c); c = mfma16(a1, bq[h][1], c);
#pragma unroll
                for (int r = 0; r < 4; ++r) s[r] += iw[h] * fmaxf(c[r], 0.f);
            }
            *(LAS f32x4*)(sc + n * 2052 + kt * 16 + 4 * g) = s;
        }
    }
    PROF_T(st1); PROF_ACC(5, st0, st1);
    LDS_BARRIER();
    PROF_T(st2); PROF_ACC(6, st1, st2);
    unsigned nxt = 0u;
    if (tid == 448) nxt = atomicAdd(ctr, 1u);
#pragma unroll 1
    for (int qi = 0; qi < 2; ++qi) {
        const int nq = wave + 8 * qi, t = t0 + nq, nw = (t >> 6) + 1; const LAS float* srow = sc + nq * 2052;
        u64 w;
        LAS unsigned* hist = (LAS unsigned*)(lds + LDS_HIST + wave * 2304);
        if (nw <= 8) w = select_row<8>(srow, t, lane, hist);
        else if (nw <= 16) w = select_row<16>(srow, t, lane, hist);
        else if (nw <= 24) w = select_row<24>(srow, t, lane, hist);
        else w = select_row<32>(srow, t, lane, hist);
        if (lane < 32) mask[((size_t)b * SEQ + t) * 32 + lane] = w;
    }
    if (tid == 448) ((volatile LAS unsigned*)(lds + LDS_QUEUE))[0] = nxt;
    PROF_T(st3); PROF_ACC(7, st2, st3);
    return true;
}

__device__ __forceinline__ void gla_seq(const Params& p, int l, int b, int h, LAS unsigned char* lds, int tid, int wave, int lane) {
    LAS bf16_t* bq = (LAS bf16_t*)(lds);
    LAS bf16_t* bk = (LAS bf16_t*)(lds + 9216);
    LAS bf16_t* bkdT = (LAS bf16_t*)(lds + 18432);
    LAS bf16_t* bvT = (LAS bf16_t*)(lds + 25344);
    LAS bf16_t* bST = (LAS bf16_t*)(lds + 39168);
    LAS float* fb = (LAS float*)(lds + 52992);
    LAS float* fs = (LAS float*)(lds + 65280);
    LAS float* fo = (LAS float*)(lds + 66816);
    for (int i = tid; i < 13248; i += 512) ((LAS unsigned*)lds)[i] = 0u;
    __syncthreads();
    const bf16_t* proj = (const bf16_t*)(p.ws + WS_PROJ); bf16_t* mix = (bf16_t*)(p.ws + WS_MIX);
    const size_t rowbase = (size_t)b * SEQ;
    const int n = lane & 15, g = lane >> 4, t_e = tid >> 3, dc = tid & 7;
    f32x4 st[3];
#pragma unroll
    for (int k = 0; k < 3; ++k) st[k] = (f32x4){0.f, 0.f, 0.f, 0.f};
    const int gtt = wave & 3, jt0 = (wave < 4) ? 0 : 2, njt = (wave < 4) ? 2 : 1;
    bf16x8 wgB[2]; float gbias[2];
#pragma unroll
    for (int q = 0; q < 2; ++q) {
        float wv[8];
#pragma unroll
        for (int i = 0; i < 8; ++i) wv[i] = (g < 2 && q < njt) ? p.wgate[((size_t)l * 16 + 8 * g + i) * 192 + h * 48 + 16 * (jt0 + q) + n] : 0.f;
        wgB[q] = as_bf8(pack8(wv)); gbias[q] = (q < njt) ? p.bgate[l * 192 + h * 48 + 16 * (jt0 + q) + n] : 0.f;
    }
    u32x4 rz = {0, 0, 0, 0}, rq = {0, 0, 0, 0}, rk = {0, 0, 0, 0}, rv0 = {0, 0, 0, 0}, rv1 = {0, 0, 0, 0};
    u32x2 rg[3] = {{0, 0}, {0, 0}, {0, 0}}, rgn[3] = {{0, 0}, {0, 0}, {0, 0}};
    float gain12[12];
#pragma unroll
    for (int i = 0; i < 12; ++i) gain12[i] = p.ogain[l * 96 + dc * 12 + i];
    const int v0t = tid / 12, v0e = tid % 12, v1t = (tid + 512) / 12, v1e = (tid + 512) % 12;
#define GLA_LOAD(cc) do { const size_t R_ = rowbase + 64 * (size_t)(cc); const bf16_t* rp_ = proj + (R_ + t_e) * NP; \
        if (dc < 6) { rq = *(const u32x4*)(rp_ + C_GQ + h * 48 + dc * 8); rk = *(const u32x4*)(rp_ + C_GK + h * 48 + dc * 8); } \
        rz = (g < 2) ? *(const u32x4*)(proj + (R_ + 16 * gtt + n) * NP + C_GGR + 8 * g) : (u32x4){0u, 0u, 0u, 0u}; \
        rv0 = *(const u32x4*)(proj + (R_ + v0t) * NP + C_GV + h * 96 + v0e * 8); \
        if (tid < 256) rv1 = *(const u32x4*)(proj + (R_ + v1t) * NP + C_GV + h * 96 + v1e * 8); \
        rgn[0] = *(const u32x2*)(rp_ + C_GZ + h * 96 + dc * 12); rgn[1] = *(const u32x2*)(rp_ + C_GZ + h * 96 + dc * 12 + 4); rgn[2] = *(const u32x2*)(rp_ + C_GZ + h * 96 + dc * 12 + 8); } while (0)
    GLA_LOAD(0);
#pragma unroll 1
    for (int c = 0; c < 32; ++c) {
        const size_t R0 = rowbase + 64 * (size_t)c;
        rg[0] = rgn[0]; rg[1] = rgn[1]; rg[2] = rgn[2];
#pragma unroll
        for (int q = 0; q < 2; ++q) {
            if (q < njt) {
                f32x4 zc = {0.f, 0.f, 0.f, 0.f};
                zc = mfma16(as_bf8(rz), wgB[q], zc);
#pragma unroll
                for (int r = 0; r < 4; ++r) { const float x = zc[r] + gbias[q]; const float ls = fminf(x, 0.f) - __logf(1.0f + __expf(-fabsf(x))); fb[(16 * gtt + 4 * g + r) * 48 + 16 * (jt0 + q) + n] = ls * 0.0625f; }
            }
        }
        LDS_BARRIER();
        float pre[8]; const int seg = tid / 48, d = tid - seg * 48;
        if (tid < 384) { float run = 0.f;
#pragma unroll
            for (int i = 0; i < 8; ++i) { run += fb[(8 * seg + i) * 48 + d]; pre[i] = run; }
            fs[seg * 48 + d] = run; }
        LDS_BARRIER();
        if (tid < 384) { float off = 0.f;
#pragma unroll
            for (int s = 0; s < 8; ++s) off += (s < seg) ? fs[s * 48 + d] : 0.f;
#pragma unroll
            for (int i = 0; i < 8; ++i) fb[(8 * seg + i) * 48 + d] = pre[i] + off; }
        LDS_BARRIER();
        if (dc < 6) {
            float q[8], k[8], qt[8], kt[8]; unpack8(rq, q); unpack8(rk, k);
#pragma unroll
            for (int i = 0; i < 8; ++i) {
                const float bb = fb[t_e * 48 + dc * 8 + i], bl = fb[63 * 48 + dc * 8 + i];
                qt[i] = q[i] * __expf(bb) * 0.14433756729740643f; kt[i] = k[i] * __expf(-bb);
                const float kd = k[i] * __expf(bl - bb);
                bkdT[(dc * 8 + i) * 72 + t_e] = (bf16_t)(pk2(kd, 0.f) & 0xffffu);
            }
            *(LAS u32x4*)(bq + t_e * 72 + dc * 8) = pack8(qt); *(LAS u32x4*)(bk + t_e * 72 + dc * 8) = pack8(kt);
        }
        {
            const unsigned wv[4] = {rv0.x, rv0.y, rv0.z, rv0.w};
#pragma unroll
            for (int i = 0; i < 4; ++i) { bvT[(v0e * 8 + 2 * i) * 72 + v0t] = (bf16_t)(wv[i] & 0xffffu); bvT[(v0e * 8 + 2 * i + 1) * 72 + v0t] = (bf16_t)(wv[i] >> 16); }
            if (tid < 256) { const unsigned wu[4] = {rv1.x, rv1.y, rv1.z, rv1.w};
#pragma unroll
                for (int i = 0; i < 4; ++i) { bvT[(v1e * 8 + 2 * i) * 72 + v1t] = (bf16_t)(wu[i] & 0xffffu); bvT[(v1e * 8 + 2 * i + 1) * 72 + v1t] = (bf16_t)(wu[i] >> 16); } }
        }
        LDS_BARRIER();
        if (c + 1 < 32) GLA_LOAD(c + 1);
        {
            const int it = wave & 3, eh = wave >> 2;
            bf16x8 qB[2];
#pragma unroll
            for (int ks = 0; ks < 2; ++ks) qB[ks] = as_bf8(*(const LAS u32x4*)(bq + (16 * it + n) * 72 + 32 * ks + 8 * g));
            f32x4 at[4];
#pragma unroll
            for (int jt = 0; jt < 4; ++jt) {
                f32x4 cc = {0.f, 0.f, 0.f, 0.f};
                if (jt <= it) {
                    const bf16x8 a0 = as_bf8(*(const LAS u32x4*)(bk + (16 * jt + n) * 72 + 8 * g)), a1 = as_bf8(*(const LAS u32x4*)(bk + (16 * jt + n) * 72 + 32 + 8 * g));
                    cc = mfma16(a0, qB[0], cc); cc = mfma16(a1, qB[1], cc);
                    if (jt == it) {
#pragma unroll
                        for (int r = 0; r < 4; ++r) if (4 * g + r > n) cc[r] = 0.f;
                    }
                }
                at[jt] = cc;
            }
            bf16x8 pf[2];
#pragma unroll
            for (int s2 = 0; s2 < 2; ++s2) { u32x4 w; w.x = pk2(at[2 * s2][0], at[2 * s2][1]); w.y = pk2(at[2 * s2][2], at[2 * s2][3]); w.z = pk2(at[2 * s2 + 1][0], at[2 * s2 + 1][1]); w.w = pk2(at[2 * s2 + 1][2], at[2 * s2 + 1][3]); pf[s2] = as_bf8(w); }
#pragma unroll
            for (int ei = 0; ei < 3; ++ei) {
                const int et = 3 * eh + ei; f32x4 oa = {0.f, 0.f, 0.f, 0.f};
#pragma unroll
                for (int s2 = 0; s2 < 2; ++s2) {
                    const u32x2 lo = *(const LAS u32x2*)(bvT + (16 * et + n) * 72 + 32 * s2 + 4 * g), hi = *(const LAS u32x2*)(bvT + (16 * et + n) * 72 + 32 * s2 + 16 + 4 * g);
                    u32x4 w; w.x = lo.x; w.y = lo.y; w.z = hi.x; w.w = hi.y;
                    oa = mfma16(as_bf8(w), pf[s2], oa);
                }
#pragma unroll
                for (int ks = 0; ks < 2; ++ks) oa = mfma16(as_bf8(*(const LAS u32x4*)(bST + (16 * et + n) * 72 + 32 * ks + 8 * g)), qB[ks], oa);
                *(LAS f32x4*)(fo + (16 * it + n) * 100 + 16 * et + 4 * g) = oa;
            }
#pragma unroll
            for (int kk = 0; kk < 3; ++kk) {
                const int tile = wave + 8 * kk;
                if (tile < 18) {
                    const int et = tile / 3, dtl = tile % 3; const float dec = __expf(fb[63 * 48 + 16 * dtl + n]);
                    f32x4 acc = st[kk] * dec;
#pragma unroll
                    for (int ks = 0; ks < 2; ++ks) acc = mfma16(as_bf8(*(const LAS u32x4*)(bvT + (16 * et + n) * 72 + 32 * ks + 8 * g)), as_bf8(*(const LAS u32x4*)(bkdT + (16 * dtl + n) * 72 + 32 * ks + 8 * g)), acc);
                    st[kk] = acc;
                }
            }
        }
        LDS_BARRIER();
#pragma unroll
        for (int kk = 0; kk < 3; ++kk) {
            const int tile = wave + 8 * kk;
            if (tile < 18) { const int et = tile / 3, dtl = tile % 3;
#pragma unroll
                for (int r = 0; r < 4; ++r) bST[(16 * et + 4 * g + r) * 72 + 16 * dtl + n] = (bf16_t)(pk2(st[kk][r], 0.f) & 0xffffu); }
        }
        {
            const int e0 = dc * 12; float v[12];
#pragma unroll
            for (int j = 0; j < 3; ++j) { const f32x4 x = *(const LAS f32x4*)(fo + t_e * 100 + e0 + 4 * j); v[4 * j] = x[0]; v[4 * j + 1] = x[1]; v[4 * j + 2] = x[2]; v[4 * j + 3] = x[3]; }
            float ss = 0.f;
#pragma unroll
            for (int i = 0; i < 12; ++i) ss += v[i] * v[i];
            ss += __shfl_xor(ss, 1); ss += __shfl_xor(ss, 2); ss += __shfl_xor(ss, 4);
            const float rin = __builtin_amdgcn_rsqf(ss * (1.0f / 96.0f) + 1e-6f);
            bf16_t* op = mix + (R0 + t_e) * DM + 640 + h * 96 + e0;
#pragma unroll
            for (int j = 0; j < 3; ++j) {
                const u32x2 zw = rg[j];
                const float o0 = v[4 * j] * rin * gain12[4 * j] * silu_f(bf_lo(zw.x)), o1 = v[4 * j + 1] * rin * gain12[4 * j + 1] * silu_f(bf_hi(zw.x));
                const float o2 = v[4 * j + 2] * rin * gain12[4 * j + 2] * silu_f(bf_lo(zw.y)), o3 = v[4 * j + 3] * rin * gain12[4 * j + 3] * silu_f(bf_hi(zw.y));
                u32x2 w; w.x = pk2(o0, o1); w.y = pk2(o2, o3); *(u32x2*)(op + 4 * j) = w;
            }
        }
    }
#undef GLA_LOAD
    __syncthreads();
}

__device__ __forceinline__ void att_qk(const LAS bf16_t* Kb, const bf16x8 (&qf)[2][2], f32x4 (&s)[2][4], int n, int g) {
#pragma unroll
    for (int ks = 0; ks < 4; ++ks) {
        const bf16x8 a0 = as_bf8(*(const LAS u32x4*)(Kb + (16 * ks + n) * 72 + 8 * g)), a1 = as_bf8(*(const LAS u32x4*)(Kb + (16 * ks + n) * 72 + 32 + 8 * g));
#pragma unroll
        for (int qi = 0; qi < 2; ++qi) { f32x4 c = {0.f, 0.f, 0.f, 0.f}; c = mfma16(a0, qf[qi][0], c); c = mfma16(a1, qf[qi][1], c); s[qi][ks] = c; }
    }
}
__device__ __forceinline__ void att_softmax_pv(const LAS bf16_t* Vt, const LAS u64* mkrow0, int kt, f32x4 (&s)[2][4], f32x4 (&o)[2][4], float (&lsum)[2], int n, int g) {
    bf16x8 pf[2][2];
#pragma unroll
    for (int qi = 0; qi < 2; ++qi) {
        const u64 mw = mkrow0[qi * 16 * 33 + kt];
        const unsigned mlo = (unsigned)(mw >> (4 * g)), mhi = (unsigned)(mw >> (32 + 4 * g));
        float ps = 0.f;
#pragma unroll
        for (int ks = 0; ks < 4; ++ks)
#pragma unroll
            for (int r = 0; r < 4; ++r) {
                const unsigned word = (ks < 2) ? mlo : mhi; const int idx = 16 * (ks & 1) + r;
                const int mm = ((int)(word << (31 - idx))) >> 31;
                const float pv = __uint_as_float(__float_as_uint(__builtin_amdgcn_exp2f(s[qi][ks][r])) & (unsigned)mm);
                s[qi][ks][r] = pv; ps += pv;
            }
        lsum[qi] += ps;
#pragma unroll
        for (int s2 = 0; s2 < 2; ++s2) { u32x4 w; w.x = pk2(s[qi][2 * s2][0], s[qi][2 * s2][1]); w.y = pk2(s[qi][2 * s2][2], s[qi][2 * s2][3]); w.z = pk2(s[qi][2 * s2 + 1][0], s[qi][2 * s2 + 1][1]); w.w = pk2(s[qi][2 * s2 + 1][2], s[qi][2 * s2 + 1][3]); pf[qi][s2] = as_bf8(w); }
    }
#pragma unroll
    for (int dt = 0; dt < 4; ++dt)
#pragma unroll
        for (int s2 = 0; s2 < 2; ++s2) {
            const u32x2 lo = *(const LAS u32x2*)(Vt + (16 * dt + n) * 72 + 32 * s2 + 4 * g), hi = *(const LAS u32x2*)(Vt + (16 * dt + n) * 72 + 32 * s2 + 16 + 4 * g);
            u32x4 w; w.x = lo.x; w.y = lo.y; w.z = hi.x; w.w = hi.y;
#pragma unroll
            for (int qi = 0; qi < 2; ++qi) o[qi][dt] = mfma16(as_bf8(w), pf[qi][s2], o[qi][dt]);
        }
}
__device__ __forceinline__ void attn_unit(const Params& p, int b, int qb, int h0, LAS unsigned char* lds, int tid, int wave, int lane) {
    LAS u64* mk = (LAS u64*)lds;
    LAS bf16_t* KB = (LAS bf16_t*)(lds + 67584);
    LAS bf16_t* VT = (LAS bf16_t*)(lds + 67584 + 36864);
    const bf16_t* vTg = (const bf16_t*)(p.ws + WS_VT);
    const bf16_t* proj = (const bf16_t*)(p.ws + WS_PROJ); bf16_t* mix = (bf16_t*)(p.ws + WS_MIX); const u64* mask = (const u64*)(p.ws + WS_MASK);
    const int t0 = qb * 256, nt = 4 * qb + 4;
    const size_t rowb = (size_t)b * SEQ;
    __syncthreads();
#pragma unroll 4
    for (int idx = tid; idx < 256 * 32; idx += 512) { const int q = idx >> 5, w = idx & 31; if (w < nt) mk[q * 33 + w] = mask[(rowb + t0 + q) * 32 + w]; }
    __syncthreads();
    const int n = lane & 15, g = lane >> 4;
    const size_t qrow = rowb + t0 + 32 * wave + n;
    const LAS u64* mkrow0 = mk + (32 * wave + n) * 33;
    const int skey = tid >> 3, sc8 = tid & 7;
#pragma unroll 1
    for (int hh = 0; hh < 3; ++hh) {
        const int h = h0 + hh;
        bf16x8 qf[2][2];
#pragma unroll
        for (int qi = 0; qi < 2; ++qi)
#pragma unroll
            for (int ks = 0; ks < 2; ++ks) qf[qi][ks] = as_bf8(*(const u32x4*)(proj + (qrow + 16 * qi) * NP + C_Q + h * 64 + ks * 32 + g * 8));
        f32x4 o[2][4];
#pragma unroll
        for (int qi = 0; qi < 2; ++qi)
#pragma unroll
            for (int dt = 0; dt < 4; ++dt) o[qi][dt] = (f32x4){0.f, 0.f, 0.f, 0.f};
        float lsum[2] = {0.f, 0.f};
        const bf16_t* kp = proj + (rowb + skey) * NP + C_K + h * 64 + sc8 * 8;
        const bf16_t* vp = vTg + ((size_t)(b * 6 + h) * 64 + skey) * SEQ + sc8 * 8;
        const int np = nt >> 1;
        u32x4 rk[2], rv[2];
#pragma unroll
        for (int tt = 0; tt < 2; ++tt) { rk[tt] = *(const u32x4*)(kp + (size_t)tt * 64 * NP); rv[tt] = *(const u32x4*)(vp + tt * 64); }
#define ATT_STAGE(pb) do { _Pragma("unroll") for (int tt_ = 0; tt_ < 2; ++tt_) { *(LAS u32x4*)(KB + ((pb) * 2 + tt_) * 4608 + skey * 72 + sc8 * 8) = rk[tt_]; \
            *(LAS u32x4*)(VT + ((pb) * 2 + tt_) * 4608 + skey * 72 + sc8 * 8) = rv[tt_]; } } while (0)
        ATT_STAGE(0);
        __syncthreads();
#pragma unroll 1
        for (int pp = 0; pp < np; ++pp) {
            if (pp + 1 < np) {
#pragma unroll
                for (int tt = 0; tt < 2; ++tt) { rk[tt] = *(const u32x4*)(kp + (size_t)(2 * pp + 2 + tt) * 64 * NP); rv[tt] = *(const u32x4*)(vp + (2 * pp + 2 + tt) * 64); }
            }
            const LAS bf16_t* Kb = KB + (pp & 1) * 9216; const LAS bf16_t* Vt = VT + (pp & 1) * 9216;
            f32x4 sA[2][4], sB[2][4];
            att_qk(Kb, qf, sA, n, g);
            att_qk(Kb + 4608, qf, sB, n, g);
            att_softmax_pv(Vt, mkrow0, 2 * pp, sA, o, lsum, n, g);
            att_softmax_pv(Vt + 4608, mkrow0, 2 * pp + 1, sB, o, lsum, n, g);
            if (pp + 1 < np) ATT_STAGE((pp + 1) & 1);
            LDS_BARRIER();
        }
#undef ATT_STAGE
#pragma unroll
        for (int qi = 0; qi < 2; ++qi) {
            float lt = lsum[qi]; lt += __shfl_xor(lt, 16); lt += __shfl_xor(lt, 32);
            const float inv = __builtin_amdgcn_rcpf(lt);
            const bf16_t* azp = proj + (qrow + 16 * qi) * NP + C_AZ + h * 64 + 4 * g; bf16_t* op = mix + (qrow + 16 * qi) * DM + h * 64 + 4 * g;
#pragma unroll
            for (int dt = 0; dt < 4; ++dt) {
                const u32x2 zw = *(const u32x2*)(azp + 16 * dt);
                const float o0 = o[qi][dt][0] * inv * silu_f(bf_lo(zw.x)), o1 = o[qi][dt][1] * inv * silu_f(bf_hi(zw.x)), o2 = o[qi][dt][2] * inv * silu_f(bf_lo(zw.y)), o3 = o[qi][dt][3] * inv * silu_f(bf_hi(zw.y));
                u32x2 w; w.x = pk2(o0, o1); w.y = pk2(o2, o3); *(u32x2*)(op + 16 * dt) = w;
            }
        }
    }
}

#define XB_TMO      128
#define XB_XCNT(j)  (256  + 64 * (j))
#define XB_XSUB(j)  (1280 + 64 * (j))
#define XB_XGEN(j)  (2304 + 64 * (j))
#define XB_TOP      3328
#define XB_TOPGEN   3392
#define XCD_BAR_WORDS 3456
#define XB_SPIN_CAP (1u << 18)

__device__ __forceinline__ unsigned xb_ld(unsigned* p)              { return __hip_atomic_load(p, __ATOMIC_RELAXED, __HIP_MEMORY_SCOPE_AGENT); }
__device__ __forceinline__ unsigned xb_add(unsigned* p, unsigned v) { return __hip_atomic_fetch_add(p, v, __ATOMIC_RELAXED, __HIP_MEMORY_SCOPE_AGENT); }
__device__ __forceinline__ unsigned xb_xcc_id() { return (unsigned)__builtin_amdgcn_s_getreg((3 << 11) | 20) & 0xFu; }
#define XB_SPIN(cond, bar) do { unsigned _sp = 0; while (cond) { __builtin_amdgcn_s_sleep(1); \
    if ((++_sp & 255u) == 0u) { if (xb_ld(&(bar)[XB_TMO])) break; if (_sp > XB_SPIN_CAP) { atomicAdd(&(bar)[XB_TMO], 1u); break; } } } } while (0)

struct XcdBarrier {
    unsigned* bar; unsigned x;
    volatile LAS unsigned* st;
};

__device__ __forceinline__ XcdBarrier xcd_barrier_post(unsigned* bar, volatile LAS unsigned* st) {
    XcdBarrier b; b.bar = bar; b.x = xb_xcc_id(); b.st = st;
    if (threadIdx.x == 0) (void)xb_add(&bar[XB_XCNT(b.x)], 1u);
    return b;
}
__device__ __forceinline__ void xcd_barrier_complete(unsigned* bar, unsigned x, unsigned& nloc, unsigned& nx) {
    const unsigned G = gridDim.x * gridDim.y * gridDim.z;
    unsigned sum, cnt, mine, sp = 0u;
    for (;;) {
        sum = 0u; cnt = 0u; mine = 0u;
#pragma unroll
        for (unsigned j = 0; j < 16; ++j) { const unsigned c = xb_ld(&bar[XB_XCNT(j)]); sum += c; cnt += (c > 0u) ? 1u : 0u; mine = (j == x) ? c : mine; }
        if (sum == G) break;
        __builtin_amdgcn_s_sleep(1);
        if ((++sp & 255u) == 0u) { if (xb_ld(&bar[XB_TMO])) break; if (sp > XB_SPIN_CAP) { atomicAdd(&bar[XB_TMO], 1u); break; } }
    }
    nloc = mine > 0u ? mine : 1u; nx = cnt > 0u ? cnt : 1u;
}

__device__ __forceinline__ void xcd_barrier(const XcdBarrier& b) {
    asm volatile("s_waitcnt vmcnt(0)" ::: "memory");
    __syncthreads();
    if (threadIdx.x == 0) {
        unsigned* bar = b.bar;
        __builtin_amdgcn_s_waitcnt(0);
        unsigned nloc = b.st[0], nx = b.st[1];
        if (nloc == 0u) { xcd_barrier_complete(bar, b.x, nloc, nx); b.st[0] = nloc; b.st[1] = nx; }
        const unsigned old = xb_add(&bar[XB_XSUB(b.x)], 1u);
        const unsigned gen = old / nloc;
        if (old + 1u == (gen + 1u) * nloc) {
            __builtin_amdgcn_fence(__ATOMIC_RELEASE, "agent");
            asm volatile("s_waitcnt vmcnt(0)" ::: "memory");
            const unsigned og = xb_add(&bar[XB_TOP], 1u);
            const unsigned tg = og / nx;
            if (og + 1u == (tg + 1u) * nx) xb_add(&bar[XB_TOPGEN], 1u);
            else XB_SPIN(xb_ld(&bar[XB_TOPGEN]) == tg, bar);
            __builtin_amdgcn_fence(__ATOMIC_ACQUIRE, "agent");
            xb_add(&bar[XB_XGEN(b.x)], 1u);
            asm volatile("s_waitcnt vmcnt(0)" ::: "memory");
        } else {
            XB_SPIN(xb_ld(&bar[XB_XGEN(b.x)]) == gen, bar);
            __builtin_amdgcn_fence(__ATOMIC_ACQUIRE, "agent");
            asm volatile("s_waitcnt vmcnt(0)" ::: "memory");
        }
    }
    __syncthreads();
}


__global__ void __launch_bounds__(512, 2) mega_fwd(Params pin) {
    extern __shared__ __attribute__((aligned(16))) unsigned char lds_raw[];
    LAS unsigned char* lds = (LAS unsigned char*)lds_raw;
    cg::grid_group grid = cg::this_grid();
#ifdef PROBE_SEC
    if (threadIdx.x == 0) ((volatile LAS unsigned long long*)(lds + LDS_PROF))[0] = 0ull;
#endif
    XcdBarrier xbar; xbar.bar = nullptr; xbar.x = 0; xbar.st = nullptr;
    if (!MULTI_LAUNCH) {
        volatile LAS unsigned* st = (volatile LAS unsigned*)(lds + LDS_XBST);
        if (threadIdx.x == 0) { st[0] = 0u; st[1] = 0u; }
        __syncthreads();
        xbar = xcd_barrier_post((unsigned*)(pin.ws + WS_CTL) + CW_BAR, st);
    }
#pragma unroll 1
    for (int ph = pin.lo; ph < pin.hi; ++ph) {
#ifdef PROBE_SUB
        const int nrep = ((ph > 0 && (ph - 1) % 5 == PROBE_SUB) || (ph == 0 && PROBE_SUB == 5)) ? 2 : 1;
#else
        const int nrep = 1;
#endif
#pragma unroll 1
        for (int rep = 0; rep < nrep; ++rep) {
        int tid = threadIdx.x; asm volatile("" : "+v"(tid));
        Params p = pin; { size_t z_ = 0; asm volatile("" : "+s"(z_)); p.ws = pin.ws + z_; }
        const int lane = tid & 63, wave = __builtin_amdgcn_readfirstlane(tid >> 6);
        const int G = gridDim.x, bid = blockIdx.x;
        const int gw = bid * 8 + wave, ngw = G * 8;
        bf16_t* XB = (bf16_t*)(p.ws + WS_XB); bf16_t* PROJ = (bf16_t*)(p.ws + WS_PROJ); bf16_t* MIX = (bf16_t*)(p.ws + WS_MIX); float* RINV = (float*)(p.ws + WS_RINV);
        if (rep) __syncthreads();
        if (ph == 0) {
            phase_weights(p, lds, gw, ngw, wave, lane);
            phase_prep_x(p, p.x, gw, ngw, lane);
        } else {
            const int l = (ph - 1) / 5, sub = (ph - 1) % 5;
            if (sub == 0) {
                pg8::Gemm gm{XB, (const bf16_t*)(p.ws + WS_WIN) + (size_t)l * NP * DM, T_TOK, NP, DM};
                pg8::StaticOrder S; S.init(T_TOK, NP, G, bid);
                EpiProj E{PROJ, RINV};
                pg8::gemm_phase<EpiProj, pg8::StaticOrder>(lds, gm, S, E, nullptr);
            } else if (sub == 1) {
                { PROF_T(gt0); for (int gi = bid; gi < 128; gi += G) gla_seq(p, l, gi >> 2, gi & 3, lds, tid, wave, lane); PROF_T(gt1); PROF_ACC(9, gt0, gt1); }
#ifdef PROBE_GLA
                for (int gi = bid; gi < 128; gi += G) gla_seq(p, l, gi >> 2, gi & 3, lds, tid, wave, lane);
#endif
#ifdef PROBE_SEL
                { unsigned* ctr2 = (unsigned*)(p.ws + WS_CTL) + 64 * l + 32; volatile LAS unsigned* qw2 = (volatile LAS unsigned*)(lds + LDS_QUEUE);
                  for (;;) { __syncthreads(); if (tid == 0) qw2[0] = atomicAdd(ctr2, 1u); __syncthreads(); const int item = (int)qw2[0]; if (item >= 4096) break; (void)sel_item(p, item & 31, 127 - (item >> 5), lds, tid, wave, lane, ctr2 + 8); } }
#endif
                unsigned* ctr = (unsigned*)(p.ws + WS_CTL) + 64 * l + 16 * rep;
                volatile LAS unsigned* qw = (volatile LAS unsigned*)(lds + LDS_QUEUE);
                bool have = false;
                for (;;) {
                    int tq = tid; asm volatile("" : "+v"(tq));
                    const int lq = tq & 63, wq = __builtin_amdgcn_readfirstlane(tq >> 6);
                    LDS_BARRIER();
                    if (!have) { if (tq == 0) qw[0] = atomicAdd(ctr, 1u); LDS_BARRIER(); }
                    const int item = (int)qw[0];
                    LDS_BARRIER();
                    have = false;
                    if (item >= 4096 + 1024 + 256) break;
                    if (item < 4096) have = sel_item(p, item & 31, 127 - (item >> 5), lds, tq, wq, lq, ctr);
                    else if (item < 5120) { if (rep == nrep - 1) qknorm_item(p, l, item - 4096, tq, lds); }
                    else pool_item(p, item - 5120, tq);
                }
            } else if (sub == 2) {
                for (int pj = bid; pj < 256; pj += G) {
                    const int pi = (G == 256) ? ((pj & 7) * 32 + (pj >> 3)) : pj;
                    const int b = pi >> 3, pp = (pi >> 1) & 3, h0 = 3 * (pi & 1);
                    attn_unit(p, b, 7 - pp, h0, lds, tid, wave, lane);
                    attn_unit(p, b, pp, h0, lds, tid, wave, lane);
                }
            } else if (sub == 3) {
                pg8::Gemm gm{MIX, (const bf16_t*)(p.ws + WS_WOUT) + (size_t)l * DM * DM, T_TOK, DM, DM};
                pg8::StaticOrder S; S.init(T_TOK, DM, G, bid);
                if (l == 0) { EpiOut0 E{XB}; pg8::gemm_phase<EpiOut0, pg8::StaticOrder>(lds, gm, S, E, nullptr); }
                else { EpiOut1 E{XB, rep == nrep - 1 ? p.out : (float*)PROJ}; pg8::gemm_phase<EpiOut1, pg8::StaticOrder>(lds, gm, S, E, nullptr); }
            } else {
                if (l == 0) phase_rinv_bf16(p, gw, ngw, lane);
            }
        }
        }
        if (ph + 1 < pin.hi) { if (MULTI_LAUNCH || pin.lo > pin.hi) grid.sync(); else xcd_barrier(xbar); }
    }
#ifdef PROBE_SEC
    if (blockIdx.x == PROBE_BLK && threadIdx.x == 0) {
        const unsigned long long acc = ((volatile LAS unsigned long long*)(lds + LDS_PROF))[0], s0 = clock64();
        while ((unsigned long long)clock64() - s0 < acc) __builtin_amdgcn_s_sleep(8);
    }
#endif
}

extern "C" void kernel_launch(void* const* d_in, const int* in_sizes, int n_in, void* d_out, int out_size, void* d_ws, size_t ws_size, hipStream_t stream) {
    static int grid_blocks = 0;
    if (!grid_blocks) {
        if (n_in != 11 || ws_size < WS_END) { fprintf(stderr, "kernel_launch: unexpected inputs (n_in %d, ws %zu)\n", n_in, ws_size); return; }
        if (hipFuncSetAttribute((const void*)mega_fwd, hipFuncAttributeMaxDynamicSharedMemorySize, LDS_BYTES) != hipSuccess) { fprintf(stderr, "kernel_launch: hipFuncSetAttribute failed\n"); return; }
        int dev = 0, cus = 0, per_cu = 0;
        (void)hipGetDevice(&dev); (void)hipDeviceGetAttribute(&cus, hipDeviceAttributeMultiprocessorCount, dev);
        (void)hipOccupancyMaxActiveBlocksPerMultiprocessor(&per_cu, mega_fwd, 512, LDS_BYTES);
        if (per_cu < 1) { fprintf(stderr, "kernel_launch: occupancy query says 0 blocks per CU\n"); return; }
        grid_blocks = cus * per_cu; if (grid_blocks > 256) grid_blocks = 256;
    }
    Params p{};
    p.x = (const float*)d_in[0]; p.norm_g = (const float*)d_in[1]; p.w_in = (const float*)d_in[2]; p.qg = (const float*)d_in[3]; p.kg = (const float*)d_in[4];
    p.pool_w = (const float*)d_in[5]; p.pool_scale = (const float*)d_in[6]; p.wgate = (const float*)d_in[7]; p.bgate = (const float*)d_in[8]; p.ogain = (const float*)d_in[9];
    p.w_out = (const float*)d_in[10]; p.out = (float*)d_out; p.ws = (unsigned char*)d_ws;
    (void)hipMemsetAsync((char*)d_ws + WS_CTL, 0, CTL_BYTES, stream);
#if MULTI_LAUNCH
    for (int ph = 0; ph < N_PHASES; ++ph) { p.lo = ph; p.hi = ph + 1; hipLaunchKernelGGL(mega_fwd, dim3(grid_blocks), dim3(512), LDS_BYTES, stream, p); }
#else
    p.lo = 0; p.hi = N_PHASES;
    void* args[] = {&p};
    hipError_t e = hipLaunchCooperativeKernel((const void*)mega_fwd, dim3(grid_blocks), dim3(512), args, LDS_BYTES, stream);
    if (e != hipSuccess) fprintf(stderr, "cooperative launch failed: %s (grid %d)\n", hipGetErrorString(e), grid_blocks);
#endif
}
```

```cpp
#include <hip/hip_runtime.h>
#include <hip/hip_cooperative_groups.h>
#include <cstdio>
#include <cstdint>
namespace cg = cooperative_groups;
namespace pg8 {
#define PG8_LAS __attribute__((address_space(3)))
typedef unsigned short bf16_t;
typedef short bf16x8 __attribute__((ext_vector_type(8)));
typedef float f32x4 __attribute__((ext_vector_type(4)));
typedef unsigned u32x4 __attribute__((ext_vector_type(4)));
constexpr int BM = 256, BK = 64, HALF = 128, HTB = HALF * BK * 2  , STAGE_BYTES = 8 * HTB, NXCD = 8, WGM = 8;

__host__ __device__ __forceinline__ int lds_byte(int r, int c) { const int st = (r >> 4) * 2 + (c >> 5), rr = r & 15, cc = c & 31, ob = rr * 64 + cc * 2; return st * 1024 + (ob ^ (((ob >> 9) & 1) << 5)); }
__host__ __device__ __forceinline__ void stage_rc(int b, int& R, int& C) { const int st = b / 1024, sb = b % 1024, swz = sb ^ (((sb >> 9) & 1) << 5); R = (st >> 1) * 16 + swz / 64; C = (st & 1) * 32 + (swz % 64) / 2; }
__host__ __device__ __forceinline__ int perm32(int rho) { const int n = rho >> 4, i = rho & 15; return 8 * (i >> 2) + 4 * n + (i & 3); }

struct Unit { int pm, pn; };
struct Gemm { const bf16_t* A; const bf16_t* Bt; int M, N, K; };

struct StaticOrder {
    int nM, nN, nwg, G, c;
    __host__ __device__ void init(int M, int N, int G_, int c_) { nM = M / BM; nN = N / BM; nwg = nM * nN; G = G_; c = c_; }
    __host__ __device__ bool next(int i, Unit& u) const {
        const long L = (long)i * G + c; if (L >= nwg) return false;
        int wgid = (int)L; { const int q = nwg / NXCD, r = nwg % NXCD, xcd = wgid % NXCD, off = wgid / NXCD; wgid = (xcd < r ? xcd * (q + 1) : r * (q + 1) + (xcd - r) * q) + off; }
        const int nig = WGM * nN, gid = wgid / nig, fm = gid * WGM, gsz = (nM - fm) < WGM ? (nM - fm) : WGM;
        u.pm = fm + ((wgid % nig) % gsz); u.pn = (wgid % nig) / gsz; return true;
    }
    __device__ __forceinline__ void a_ready(const Unit&) const {}
    __device__ __forceinline__ void done(const Unit&) const {}
};
__device__ __forceinline__ unsigned cvt_pk_bf16(float lo, float hi) { unsigned r; asm volatile("v_cvt_pk_bf16_f32 %0, %1, %2" : "=v"(r) : "v"(lo), "v"(hi)); return r; }
template <class Epi, class Sched, bool STAMP = false>
__device__ __forceinline__ void gemm_phase(PG8_LAS unsigned char* lds, const Gemm g, const Sched& S, const Epi& E, unsigned long long* stamps) {
    int tid_l = threadIdx.x; asm volatile("" : "+v"(tid_l));
    const int tid = tid_l, wid = __builtin_amdgcn_readfirstlane(tid >> 6), lane = tid & 63, wr = wid >> 2, wc = wid & 3, fr = lane & 15, fq = lane >> 4;
    const int K = g.K, nt = K / BK;
    int ts_lo = 0, ts_hi = 0, nts = 0; const unsigned long long rt_entry = STAMP ? (unsigned long long)wall_clock64() : 0ull;
#define PG8_STAMP() do { if (STAMP && wid == 0 && nts < 64) { const unsigned long long _c = (unsigned long long)clock64(); \
        ts_lo = (lane == nts) ? (int)(unsigned)_c : ts_lo; ts_hi = (lane == nts) ? (int)(unsigned)(_c >> 32) : ts_hi; ++nts; } } while (0)
    PG8_STAMP();
    unsigned voffA[2], voffB[2];
#pragma unroll
    for (int i = 0; i < 2; ++i) { int R, C; stage_rc(tid * 16 + i * 8192, R, C); const int Rb = Epi::PERM ? ((R & ~31) + perm32(R & 31)) : R;
        voffA[i] = (unsigned)(R * K + C) * 2u; voffB[i] = (unsigned)(Rb * K + C) * 2u; }
    const size_t kstep = (size_t)(BK * 2);
    const size_t hstep = (size_t)HALF * K * 2;
    const size_t tstep = 2 * hstep;
    const unsigned ldsw = (unsigned)wid * 1024u;
    const int aoff = lds_byte(wr * 64 + fr, fq * 8), boff = lds_byte(wc * 32 + fr, fq * 8);
#define PG8_SA(b, h) (((b) * 2 + (h)) * HTB)
#define PG8_SB(b, h) ((4 + (b) * 2 + (h)) * HTB)
#define PG8_STAGE(bufoff, gbase, voff) do { _Pragma("unroll") for (int _i = 0; _i < 2; ++_i) \
        __builtin_amdgcn_global_load_lds((const unsigned*)((const char*)(gbase) + (voff)[_i]), (PG8_LAS unsigned*)(lds + (bufoff) + ldsw + _i * 8192), 16, 0, 0); } while (0)
#define PG8_LDA(dst, b, h) do { _Pragma("unroll") for (int m = 0; m < 4; ++m) _Pragma("unroll") for (int k = 0; k < 2; ++k) dst[m][k] = *(const PG8_LAS bf16x8*)(lds + PG8_SA(b, h) + aoff + m * 2048 + k * 1024); } while (0)
#define PG8_LDB(dst, b, h) do { _Pragma("unroll") for (int n = 0; n < 2; ++n) _Pragma("unroll") for (int k = 0; k < 2; ++k) dst[n][k] = *(const PG8_LAS bf16x8*)(lds + PG8_SB(b, h) + boff + n * 2048 + k * 1024); } while (0)
#define PG8_MMA(ai, bj, At, Bt) do { __builtin_amdgcn_s_setprio(1); _Pragma("unroll") for (int m = 0; m < 4; ++m) _Pragma("unroll") for (int n = 0; n < 2; ++n) _Pragma("unroll") for (int k = 0; k < 2; ++k) \
        acc[ai][bj][m][n] = __builtin_amdgcn_mfma_f32_16x16x32_bf16(Bt[n][k], At[m][k], acc[ai][bj][m][n], 0, 0, 0); __builtin_amdgcn_s_setprio(0); } while (0)
#define PG8_WAIT_V(n) asm volatile("s_waitcnt vmcnt(" #n ")" ::: "memory")
#define PG8_WAIT_L(n) asm volatile("s_waitcnt lgkmcnt(" #n ")" ::: "memory")
#define PG8_BAR __builtin_amdgcn_s_barrier()
#define PG8_SCHED __builtin_amdgcn_sched_barrier(0)
    Unit cur, nxt; int ui = 0;
    if (!S.next(0, cur)) return;
    f32x4 acc[2][2][4][2];
#pragma unroll
    for (int a = 0; a < 2; ++a)
#pragma unroll
        for (int b = 0; b < 2; ++b)
#pragma unroll
            for (int m = 0; m < 4; ++m)
#pragma unroll
                for (int n = 0; n < 2; ++n) acc[a][b][m][n] = (f32x4){0.f, 0.f, 0.f, 0.f};
    bf16x8 At[4][2], B0[2][2], B1[2][2];
    const char* cA = (const char*)g.A + (size_t)cur.pm * tstep; const char* cB = (const char*)g.Bt + (size_t)cur.pn * tstep;
    S.a_ready(cur);
    PG8_STAGE(PG8_SB(0, 0), cB, voffB); PG8_STAGE(PG8_SA(0, 0), cA, voffA); PG8_STAGE(PG8_SB(0, 1), cB + hstep, voffB); PG8_STAGE(PG8_SA(0, 1), cA + hstep, voffA);
    if (wr == 1) PG8_BAR;
    PG8_WAIT_V(4); PG8_BAR;
    PG8_STAGE(PG8_SB(1, 0), cB + kstep, voffB); PG8_STAGE(PG8_SA(1, 0), cA + kstep, voffA); PG8_STAGE(PG8_SB(1, 1), cB + hstep + kstep, voffB);
    PG8_WAIT_V(6); PG8_BAR;
    PG8_STAMP();
    for (;;) {
        const bool has_next = S.next(ui + 1, nxt);
        const char* nA = has_next ? (const char*)g.A + (size_t)nxt.pm * tstep : cA; const char* nB = has_next ? (const char*)g.Bt + (size_t)nxt.pn * tstep : cB;
        for (int t = 0; t < nt; t += 2) {
            const bool last = (t == nt - 2);
            const char* a1 = cA + (size_t)(t + 1) * kstep;
            const char* a2 = last ? nA : cA + (size_t)(t + 2) * kstep; const char* b2 = last ? nB : cB + (size_t)(t + 2) * kstep;
            const char* a3 = a2 + kstep; const char* b3 = b2 + kstep;
            if (last && has_next) S.a_ready(nxt);
            PG8_LDB(B0, 0, 0); PG8_SCHED; PG8_LDA(At, 0, 0); PG8_STAGE(PG8_SA(1, 1), a1 + hstep, voffA);
            PG8_WAIT_L(8); PG8_BAR; PG8_WAIT_L(0); PG8_MMA(0, 0, At, B0); PG8_BAR; PG8_SCHED;
            PG8_LDB(B1, 0, 1); PG8_STAGE(PG8_SB(0, 0), b2, voffB);
            PG8_BAR; PG8_WAIT_L(0); PG8_MMA(0, 1, At, B1); PG8_BAR;
            PG8_LDA(At, 0, 1); PG8_STAGE(PG8_SA(0, 0), a2, voffA);
            PG8_BAR; PG8_WAIT_L(0); PG8_MMA(1, 0, At, B0); PG8_BAR; PG8_SCHED;
            PG8_STAGE(PG8_SB(0, 1), b2 + hstep, voffB);
            PG8_WAIT_V(6); PG8_BAR; PG8_MMA(1, 1, At, B1); PG8_BAR;
            PG8_LDB(B0, 1, 0); PG8_SCHED; PG8_LDA(At, 1, 0); PG8_STAGE(PG8_SA(0, 1), a2 + hstep, voffA);
            PG8_WAIT_L(8); PG8_BAR; PG8_WAIT_L(0); PG8_MMA(0, 0, At, B0); PG8_BAR; PG8_SCHED;
            PG8_LDB(B1, 1, 1); PG8_STAGE(PG8_SB(1, 0), b3, voffB);
            PG8_BAR; PG8_WAIT_L(0); PG8_MMA(0, 1, At, B1); PG8_BAR;
            PG8_LDA(At, 1, 1); PG8_STAGE(PG8_SA(1, 0), a3, voffA);
            PG8_BAR; PG8_WAIT_L(0); PG8_MMA(1, 0, At, B0); PG8_BAR; PG8_SCHED;
            PG8_STAGE(PG8_SB(1, 1), b3 + hstep, voffB);
            PG8_WAIT_V(6); PG8_BAR; PG8_MMA(1, 1, At, B1); PG8_BAR;
        }
        PG8_STAMP();
        if constexpr (!Epi::AFTER_DRAIN) { E(acc, cur, wr, wc, fr, fq); S.done(cur); }
        PG8_STAMP();
        if (!has_next) break;
#pragma unroll
        for (int a = 0; a < 2; ++a)
#pragma unroll
            for (int b = 0; b < 2; ++b)
#pragma unroll
                for (int m = 0; m < 4; ++m)
#pragma unroll
                    for (int n = 0; n < 2; ++n) acc[a][b][m][n] = (f32x4){0.f, 0.f, 0.f, 0.f};
        cur = nxt; cA = nA; cB = nB; ++ui;
    }
    PG8_WAIT_V(0);
    if (wr == 0) PG8_BAR;
    PG8_BAR;
    if constexpr (Epi::AFTER_DRAIN) { E.fused(acc, cur, wr, wc, fr, fq, lds, wid, lane); S.done(cur); }
    PG8_STAMP();
    if (STAMP && wid == 0) { stamps[lane] = lane < nts ? (((unsigned long long)(unsigned)ts_hi << 32) | (unsigned)ts_lo) : 0ull;
        if (lane == 62) stamps[62] = rt_entry; if (lane == 63) stamps[63] = (unsigned long long)wall_clock64(); }
#undef PG8_STAMP
#undef PG8_SA
#undef PG8_SB
#undef PG8_STAGE
#undef PG8_LDA
#undef PG8_LDB
#undef PG8_MMA
#undef PG8_WAIT_V
#undef PG8_WAIT_L
#undef PG8_BAR
#undef PG8_SCHED
}
}
#define LAS __attribute__((address_space(3)))
typedef unsigned short bf16_t;
typedef short bf16x8 __attribute__((ext_vector_type(8)));
typedef float f32x4 __attribute__((ext_vector_type(4)));
typedef unsigned u32x4 __attribute__((ext_vector_type(4)));
typedef unsigned u32x2 __attribute__((ext_vector_type(2)));
typedef unsigned long long u64;

#ifndef MULTI_LAUNCH
#define MULTI_LAUNCH 0
#endif

constexpr int T_TOK = 65536, SEQ = 2048, NBATCH = 32, DM = 1024, NP = 3584, INW = 3540;
constexpr int C_Q = 0, C_K = 384, C_V = 768, C_AZ = 1152, C_IQ = 1536, C_IK = 1792, C_IW = 1856, C_GGR = 1864, C_PU = 1920, C_PZ = 2176,
              C_GQ = 2432, C_GK = 2624, C_GV = 2816, C_GZ = 3200;
constexpr int LDS_BYTES = 150528;
constexpr int LDS_HIST = 131328;
constexpr int LDS_QUEUE = 149760;
constexpr int LDS_XBST = 149824;
constexpr int LDS_PROF = 149888;
constexpr int CW_BAR = 1024;
constexpr int CTL_BYTES = 32768;
constexpr size_t MiB = 1u << 20;
constexpr size_t WS_CTL = 0, WS_WIN = 1 * MiB, WS_WOUT = 16 * MiB, WS_RINV = 20 * MiB, WS_MASK = 24 * MiB, WS_XB = 40 * MiB,
                 WS_MIX = 168 * MiB, WS_PROJ = 296 * MiB, WS_VT = 776 * MiB, WS_END = 824 * MiB;
constexpr int N_PHASES = 10;
constexpr float LOG2E = 1.4426950408889634f;

struct Params {
    const float* x; const float* norm_g; const float* w_in; const float* qg; const float* kg; const float* pool_w; const float* pool_scale;
    const float* wgate; const float* bgate; const float* ogain; const float* w_out; float* out; unsigned char* ws; int lo, hi;
};

__device__ __forceinline__ float bf_lo(unsigned w) { return __uint_as_float(w << 16); }
__device__ __forceinline__ float bf_hi(unsigned w) { return __uint_as_float(w & 0xffff0000u); }
__device__ __forceinline__ unsigned pk2(float lo, float hi) { return pg8::cvt_pk_bf16(lo, hi); }
__device__ __forceinline__ void unpack8(const u32x4 w, float (&f)[8]) {
    f[0] = bf_lo(w.x); f[1] = bf_hi(w.x); f[2] = bf_lo(w.y); f[3] = bf_hi(w.y); f[4] = bf_lo(w.z); f[5] = bf_hi(w.z); f[6] = bf_lo(w.w); f[7] = bf_hi(w.w);
}
__device__ __forceinline__ u32x4 pack8(const float (&f)[8]) { u32x4 w; w.x = pk2(f[0], f[1]); w.y = pk2(f[2], f[3]); w.z = pk2(f[4], f[5]); w.w = pk2(f[6], f[7]); return w; }
__device__ __forceinline__ f32x4 mfma16(bf16x8 a, bf16x8 b, f32x4 c) { return __builtin_amdgcn_mfma_f32_16x16x32_bf16(a, b, c, 0, 0, 0); }
__device__ __forceinline__ bf16x8 as_bf8(u32x4 w) { return __builtin_bit_cast(bf16x8, w); }
__device__ __forceinline__ float silu_f(float z) { return z * __builtin_amdgcn_rcpf(1.0f + __expf(-z)); }
__device__ __forceinline__ float wave_sum(float v) {
#pragma unroll
    for (int o = 1; o < 64; o <<= 1) v += __shfl_xor(v, o);
    return v;
}
#define LDS_WAIT() asm volatile("s_waitcnt lgkmcnt(0)" ::: "memory")
#define LDS_BARRIER() do { asm volatile("s_waitcnt lgkmcnt(0)" ::: "memory"); __builtin_amdgcn_s_barrier(); asm volatile("" ::: "memory"); } while (0)
#ifdef PROBE_SEC
#define PROF_T(v) const unsigned long long v = clock64()
#define PROF_ACC(id, t0v, t1v) do { if ((id) == PROBE_SEC && threadIdx.x == 0 && blockIdx.x == PROBE_BLK) { volatile LAS unsigned long long* pr_ = (volatile LAS unsigned long long*)(lds + LDS_PROF); pr_[0] = pr_[0] + ((t1v) - (t0v)); } } while (0)
#else
#define PROF_T(v) do {} while (0)
#define PROF_ACC(id, t0v, t1v) do {} while (0)
#endif

struct EpiProj {
    static constexpr bool PERM = true, AFTER_DRAIN = false;
    bf16_t* O; const float* rinv;
    __device__ __forceinline__ void operator()(const pg8::f32x4 (&acc)[2][2][4][2], const pg8::Unit& u, int wr, int wc, int fr, int fq) const {
        const int row0 = u.pm * 256 + wr * 64 + fr, col0 = u.pn * 256 + wc * 32 + 8 * fq;
        asm volatile("" ::: "memory");
        float rs[2][4];
#pragma unroll
        for (int ai = 0; ai < 2; ++ai)
#pragma unroll
            for (int m = 0; m < 4; ++m) rs[ai][m] = rinv[row0 + ai * 128 + m * 16];
#pragma unroll
        for (int ai = 0; ai < 2; ++ai)
#pragma unroll
            for (int m = 0; m < 4; ++m) {
                const int row = row0 + ai * 128 + m * 16; const float rsv = rs[ai][m];
                bf16_t* rowp = O + (size_t)row * NP + col0;
#pragma unroll
                for (int bj = 0; bj < 2; ++bj) {
                    const pg8::f32x4 v0 = acc[ai][bj][m][0] * rsv, v1 = acc[ai][bj][m][1] * rsv;
                    u32x4 w; w.x = pk2(v0[0], v0[1]); w.y = pk2(v0[2], v0[3]); w.z = pk2(v1[0], v1[1]); w.w = pk2(v1[2], v1[3]);
                    *(u32x4*)(rowp + bj * 128) = w;
                }
            }
    }
};
struct EpiOut0 {
    static constexpr bool PERM = false, AFTER_DRAIN = false;
    bf16_t* xb;
    __device__ __forceinline__ void operator()(const pg8::f32x4 (&acc)[2][2][4][2], const pg8::Unit& u, int wr, int wc, int fr, int fq) const {
        const int row0 = u.pm * 256 + wr * 64 + fr, col0 = u.pn * 256 + wc * 32 + 4 * fq;
#pragma unroll
        for (int ai = 0; ai < 2; ++ai)
#pragma unroll
            for (int m = 0; m < 4; ++m) {
                if (m == 0) asm volatile("" ::: "memory");
                const size_t off = (size_t)(row0 + ai * 128 + m * 16) * DM + col0;
#pragma unroll
                for (int bj = 0; bj < 2; ++bj)
#pragma unroll
                    for (int n = 0; n < 2; ++n) {
                        const u32x2 xw = *(const u32x2*)(xb + off + bj * 128 + n * 16);
                        pg8::f32x4 v; v[0] = bf_lo(xw.x); v[1] = bf_hi(xw.x); v[2] = bf_lo(xw.y); v[3] = bf_hi(xw.y);
                        v = v + acc[ai][bj][m][n];
                        u32x2 w; w.x = pk2(v[0], v[1]); w.y = pk2(v[2], v[3]); *(u32x2*)(xb + off + bj * 128 + n * 16) = w;
                    }
            }
    }
};
struct EpiOut1 {
    static constexpr bool PERM = false, AFTER_DRAIN = false;
    const bf16_t* xb; float* out;
    __device__ __forceinline__ void operator()(const pg8::f32x4 (&acc)[2][2][4][2], const pg8::Unit& u, int wr, int wc, int fr, int fq) const {
        const int row0 = u.pm * 256 + wr * 64 + fr, col0 = u.pn * 256 + wc * 32 + 4 * fq;
#pragma unroll
        for (int ai = 0; ai < 2; ++ai)
#pragma unroll
            for (int m = 0; m < 4; ++m) {
                if (m == 0) asm volatile("" ::: "memory");
                const size_t off = (size_t)(row0 + ai * 128 + m * 16) * DM + col0;
#pragma unroll
                for (int bj = 0; bj < 2; ++bj)
#pragma unroll
                    for (int n = 0; n < 2; ++n) {
                        const u32x2 w = *(const u32x2*)(xb + off + bj * 128 + n * 16);
                        pg8::f32x4 v; v[0] = bf_lo(w.x); v[1] = bf_hi(w.x); v[2] = bf_lo(w.y); v[3] = bf_hi(w.y);
                        *(pg8::f32x4*)(out + off + bj * 128 + n * 16) = v + acc[ai][bj][m][n];
                    }
            }
    }
};

__device__ __forceinline__ float win_eff(const Params& p, int l, int k, int n) {
    const float* W = p.w_in + ((size_t)l * DM + k) * INW;
    if (n < 1860) return W[n];
    if (n < C_PU) return (n >= C_GGR && n < C_GGR + 16) ? W[3140 + (n - C_GGR)] : 0.f;
    if (n < C_PZ) {
        const int gi = (n - C_PU) >> 6, d = (n - C_PU) & 63;
        const float* pw = p.pool_w + ((size_t)(l * 4 + gi) * 64) * 64 + d; const float* wr = W + 1860 + gi * 64; float s = 0.f;
        for (int c = 0; c < 64; ++c) s += wr[c] * pw[c * 64];
        return s * p.pool_scale[l * 256 + gi * 64 + d];
    }
    if (n < C_GQ) return W[2116 + (n - C_PZ)];
    if (n < C_GK) return W[2372 + (n - C_GQ)];
    if (n < C_GV) return W[2564 + (n - C_GK)];
    if (n < C_GZ) return W[2756 + (n - C_GV)];
    return W[3156 + (n - C_GZ)];
}

__device__ __forceinline__ void phase_weights(const Params& p, LAS unsigned char* lds, int gw, int ngw, int wave, int lane) {
    LAS float* scr = (LAS float*)(lds + wave * 8704);
    bf16_t* WIN = (bf16_t*)(p.ws + WS_WIN); bf16_t* WOUT = (bf16_t*)(p.ws + WS_WOUT);
    constexpr int NI_IN = 2 * 16 * 112, NI_OUT = 2 * 16 * 32;
    for (int it = gw; it < NI_IN + NI_OUT; it += ngw) {
        const int nn = lane & 31;
        bf16_t* dst; int k0, n0, ldk = DM;
        if (it < NI_IN) {
            const int l = it / 1792, r = it % 1792, kb = r / 112, nb = r % 112; k0 = 64 * kb; n0 = 32 * nb;
            if (n0 >= C_PU && n0 < C_PZ) {
                const int gi = (n0 - C_PU) >> 6, d = ((n0 - C_PU) & 63) + nn;
                const float* pw = p.pool_w + ((size_t)(l * 4 + gi) * 64) * 64 + d; const float scl = p.pool_scale[l * 256 + gi * 64 + d];
                float pwr[64];
#pragma unroll
                for (int c = 0; c < 64; ++c) pwr[c] = pw[c * 64] * scl;
#pragma unroll 2
                for (int i = 0; i < 32; ++i) {
                    const int kk = 2 * i + (lane >> 5), k = k0 + kk;
                    const f32x4* wr = (const f32x4*)(p.w_in + ((size_t)l * DM + k) * INW + 1860 + gi * 64);
                    float sa = 0.f, sb = 0.f;
#pragma unroll
                    for (int c4 = 0; c4 < 16; c4 += 2) { const f32x4 w0 = wr[c4], w1 = wr[c4 + 1];
                        sa += (w0.x * pwr[4 * c4] + w0.y * pwr[4 * c4 + 1]) + (w0.z * pwr[4 * c4 + 2] + w0.w * pwr[4 * c4 + 3]);
                        sb += (w1.x * pwr[4 * c4 + 4] + w1.y * pwr[4 * c4 + 5]) + (w1.z * pwr[4 * c4 + 6] + w1.w * pwr[4 * c4 + 7]); }
                    scr[kk * 33 + nn] = (sa + sb) * p.norm_g[l * DM + k];
                }
            } else {
#pragma unroll 4
                for (int i = 0; i < 32; ++i) { const int kk = 2 * i + (lane >> 5), k = k0 + kk; scr[kk * 33 + nn] = win_eff(p, l, k, n0 + nn) * p.norm_g[l * DM + k]; }
            }
            dst = WIN + (size_t)l * NP * DM;
        } else {
            const int r0 = it - NI_IN, l = r0 / 512, r = r0 % 512, kb = r / 32, nb = r % 32; k0 = 64 * kb; n0 = 32 * nb;
            const float* W = p.w_out + (size_t)l * DM * DM;
#pragma unroll 4
            for (int i = 0; i < 32; ++i) { const int kk = 2 * i + (lane >> 5), k = k0 + kk; scr[kk * 33 + nn] = W[(size_t)k * DM + n0 + nn]; }
            dst = WOUT + (size_t)l * DM * DM;
        }
        LDS_WAIT();
        const int c = lane & 7;
#pragma unroll
        for (int j = 0; j < 4; ++j) {
            const int n = (lane >> 3) + 8 * j; const LAS float* s = scr + (8 * c) * 33 + n;
            u32x4 o; o.x = pk2(s[0 * 33], s[1 * 33]); o.y = pk2(s[2 * 33], s[3 * 33]); o.z = pk2(s[4 * 33], s[5 * 33]); o.w = pk2(s[6 * 33], s[7 * 33]);
            *(u32x4*)(dst + (size_t)(n0 + n) * ldk + k0 + 8 * c) = o;
        }
        LDS_WAIT();
    }
}
__device__ __forceinline__ void phase_prep_x(const Params& p, const float* src, int gw, int ngw, int lane) {
    bf16_t* xb = (bf16_t*)(p.ws + WS_XB); float* rinv = (float*)(p.ws + WS_RINV);
    for (int m0 = gw * 4; m0 < T_TOK; m0 += ngw * 4) {
        f32x4 v[4][4]; float s[4];
#pragma unroll
        for (int r = 0; r < 4; ++r) { const f32x4* xr = (const f32x4*)(src + (size_t)(m0 + r) * DM) + lane;
#pragma unroll
            for (int j = 0; j < 4; ++j) v[r][j] = xr[64 * j]; }
#pragma unroll
        for (int r = 0; r < 4; ++r) { float a = 0.f;
#pragma unroll
            for (int j = 0; j < 4; ++j) a += (v[r][j].x * v[r][j].x + v[r][j].y * v[r][j].y) + (v[r][j].z * v[r][j].z + v[r][j].w * v[r][j].w);
            s[r] = wave_sum(a); }
#pragma unroll
        for (int r = 0; r < 4; ++r) {
            if (lane == 0) rinv[m0 + r] = __builtin_amdgcn_rsqf(s[r] * (1.0f / DM) + 1e-6f);
            u32x2* o8 = (u32x2*)(xb + (size_t)(m0 + r) * DM) + lane;
#pragma unroll
            for (int j = 0; j < 4; ++j) { u32x2 w; w.x = pk2(v[r][j].x, v[r][j].y); w.y = pk2(v[r][j].z, v[r][j].w); o8[64 * j] = w; }
        }
    }
}

__device__ __forceinline__ void phase_rinv_bf16(const Params& p, int gw, int ngw, int lane) {
    const bf16_t* xb = (const bf16_t*)(p.ws + WS_XB); float* rinv = (float*)(p.ws + WS_RINV);
    for (int m0 = gw * 8; m0 < T_TOK; m0 += ngw * 8) {
        u32x4 v[8][2];
#pragma unroll
        for (int r = 0; r < 8; ++r) { const u32x4* xr = (const u32x4*)(xb + (size_t)(m0 + r) * DM) + lane; v[r][0] = xr[0]; v[r][1] = xr[64]; }
#pragma unroll
        for (int r = 0; r < 8; ++r) {
            float f[8], a = 0.f;
            unpack8(v[r][0], f);
#pragma unroll
            for (int k = 0; k < 8; ++k) a += f[k] * f[k];
            unpack8(v[r][1], f);
#pragma unroll
            for (int k = 0; k < 8; ++k) a += f[k] * f[k];
            a = wave_sum(a);
            if (lane == 0) rinv[m0 + r] = __builtin_amdgcn_rsqf(a * (1.0f / DM) + 1e-6f);
        }
    }
}

__device__ __forceinline__ void qknorm_item(const Params& p, int l, int item, int tid, LAS unsigned char* lds) {
    bf16_t* proj = (bf16_t*)(p.ws + WS_PROJ);
    {
        LAS bf16_t* tv = (LAS bf16_t*)lds;
        bf16_t* vT = (bf16_t*)(p.ws + WS_VT);
        const size_t row0 = (size_t)item * 64; const int b = (int)(row0 >> 11), t0 = (int)(row0 & (SEQ - 1));
#pragma unroll
        for (int i = 0; i < 6; ++i) { const int id = tid + 512 * i, r = id / 48, c8 = id % 48; *(LAS u32x4*)(tv + r * 392 + c8 * 8) = *(const u32x4*)(proj + (row0 + r) * NP + C_V + c8 * 8); }
        LDS_BARRIER();
#pragma unroll
        for (int i = 0; i < 6; ++i) {
            const int id = tid + 512 * i, tc = id / 384, hd = id % 384;
            const LAS bf16_t* src = tv + (8 * tc) * 392 + hd;
            u32x4 w; w.x = (unsigned)src[0] | ((unsigned)src[392] << 16); w.y = (unsigned)src[2 * 392] | ((unsigned)src[3 * 392] << 16);
            w.z = (unsigned)src[4 * 392] | ((unsigned)src[5 * 392] << 16); w.w = (unsigned)src[6 * 392] | ((unsigned)src[7 * 392] << 16);
            *(u32x4*)(vT + ((size_t)b * 384 + hd) * SEQ + t0 + 8 * tc) = w;
        }
    }
    {
        u32x4 wv[12];
#pragma unroll
        for (int i = 0; i < 12; ++i) { const int idx = tid + 512 * i, r = idx / 96, ch = idx % 96; wv[i] = *(const u32x4*)(proj + ((size_t)item * 64 + r) * NP + ch * 8); }
#pragma unroll
        for (int i = 0; i < 12; ++i) {
            const int idx = tid + 512 * i, ch = idx % 96;
            float f[8]; unpack8(wv[i], f);
            float ss = 0.f;
#pragma unroll
            for (int k = 0; k < 8; ++k) ss += f[k] * f[k];
            ss += __shfl_xor(ss, 1); ss += __shfl_xor(ss, 2); ss += __shfl_xor(ss, 4);
            const float rn = __builtin_amdgcn_rsqf(ss * (1.0f / 64.0f) + 1e-6f);
            const bool isq = ch < 48; const float* gp = (isq ? p.qg : p.kg) + l * 64 + (ch & 7) * 8; const float sc = isq ? (0.125f * LOG2E) * rn : rn;
#pragma unroll
            for (int k = 0; k < 8; ++k) f[k] = f[k] * sc * gp[k];
            wv[i] = pack8(f);
        }
#pragma unroll
        for (int i = 0; i < 12; ++i) { const int idx = tid + 512 * i, r = idx / 96, ch = idx % 96; *(u32x4*)(proj + ((size_t)item * 64 + r) * NP + ch * 8) = wv[i]; }
    }
}
__device__ __forceinline__ void pool_item(const Params& p, int item, int tid) {
    const bf16_t* proj = (const bf16_t*)(p.ws + WS_PROJ); bf16_t* mix = (bf16_t*)(p.ws + WS_MIX);
    const int ch = tid & 31, rb = tid >> 5; const size_t R0 = (size_t)item * 256 + rb * 16; const int t0r = (int)(R0 & (SEQ - 1));
    const int w = 2 << (ch >> 3);
    const bf16_t* up = proj + R0 * NP + C_PU + ch * 8; const bf16_t* zp = proj + R0 * NP + C_PZ + ch * 8;
    float acc[8], f[8], g[8];
#pragma unroll
    for (int k = 0; k < 8; ++k) acc[k] = 0.f;
    for (int j = 1; j < w; ++j) if (t0r - j >= 0) { unpack8(*(const u32x4*)(up - (size_t)j * NP), f);
#pragma unroll
        for (int k = 0; k < 8; ++k) acc[k] += f[k]; }
    u32x4 outv[16];
#pragma unroll
    for (int i = 0; i < 16; ++i) {
        const int t = t0r + i;
        unpack8(*(const u32x4*)(up + (size_t)i * NP), f);
#pragma unroll
        for (int k = 0; k < 8; ++k) acc[k] += f[k];
        const int cnt = (t + 1 < w) ? (t + 1) : w; const float ic = __builtin_amdgcn_rcpf((float)cnt);
        unpack8(*(const u32x4*)(zp + (size_t)i * NP), g);
#pragma unroll
        for (int k = 0; k < 8; ++k) g[k] = (acc[k] * ic - f[k]) * silu_f(g[k]);
        outv[i] = pack8(g);
        if (t - w + 1 >= 0) { unpack8(*(const u32x4*)(up + ((ptrdiff_t)i - (w - 1)) * NP), f);
#pragma unroll
            for (int k = 0; k < 8; ++k) acc[k] -= f[k]; }
    }
#pragma unroll
    for (int i = 0; i < 16; ++i) *(u32x4*)(mix + (R0 + i) * DM + 384 + ch * 8) = outv[i];
}

__device__ __forceinline__ unsigned f2ord(float f) { const unsigned b = __float_as_uint(f); return b ^ ((b >> 31) ? 0xFFFFFFFFu : 0x80000000u); }
__device__ __forceinline__ void hist_find(const LAS unsigned* hist, int lane, int R, int& B, int& cab, int& nB) {
    const u32x4 a = ((const LAS u32x4*)hist)[2 * lane], b = ((const LAS u32x4*)hist)[2 * lane + 1];
    const unsigned h[8] = {a.x, a.y, a.z, a.w, b.x, b.y, b.z, b.w};
    const unsigned s8 = (h[0] + h[1]) + (h[2] + h[3]) + (h[4] + h[5]) + (h[6] + h[7]);
    unsigned v = s8;
#pragma unroll
    for (int off = 1; off < 64; off <<= 1) { const unsigned tt = (unsigned)__shfl_down((int)v, off); v += (lane + off < 64) ? tt : 0u; }
    const int sx = (int)(v - s8);
    const bool mine = (sx < R) && (R <= (int)v);
    int c = sx, Bk = 0, cabk = 0, nk = 0; bool found = false;
#pragma unroll
    for (int k = 7; k >= 0; --k) { if (!found && c + (int)h[k] >= R) { Bk = 8 * lane + k; cabk = c; nk = (int)h[k]; found = true; } c += (int)h[k]; }
    const u64 mm = __ballot(mine); const int src = mm ? (__ffsll((long long)mm) - 1) : 0;
    B = __builtin_amdgcn_readfirstlane(__shfl(Bk, src)); cab = __builtin_amdgcn_readfirstlane(__shfl(cabk, src)); nB = __builtin_amdgcn_readfirstlane(__shfl(nk, src));
}
template <int NJ>
__device__ __forceinline__ u64 select_row(const LAS float* srow, int t, int lane, LAS unsigned* hist) {
    float f[NJ]; int k18[NJ]; float fmx = -INFINITY, fmn = INFINITY;
#pragma unroll
    for (int j = 0; j < NJ; ++j) {
        const int key = j * 64 + lane; const float v = srow[key]; const bool valid = key <= t;
        f[j] = v; k18[j] = valid ? 0 : -1; fmx = fmaxf(fmx, valid ? v : -INFINITY); fmn = fminf(fmn, valid ? v : INFINITY);
    }
#pragma unroll
    for (int off = 32; off; off >>= 1) { fmx = fmaxf(fmx, __shfl_xor(fmx, off)); fmn = fminf(fmn, __shfl_xor(fmn, off)); }
    const float lo_f = __uint_as_float((unsigned)__builtin_amdgcn_readfirstlane((int)__float_as_uint(fmn)));
    const float hi_f = __uint_as_float((unsigned)__builtin_amdgcn_readfirstlane((int)__float_as_uint(fmx)));
    u64 myword = 0ull; bool fast = false;
    if (hi_f > lo_f) {
        const float sc18 = 262143.0f / (hi_f - lo_f);
        ((LAS u32x4*)hist)[2 * lane] = (u32x4){0u, 0u, 0u, 0u}; ((LAS u32x4*)hist)[2 * lane + 1] = (u32x4){0u, 0u, 0u, 0u};
        LDS_WAIT();
#pragma unroll
        for (int j = 0; j < NJ; ++j) {
            const bool valid = k18[j] >= 0; const unsigned kk = min((unsigned)((f[j] - lo_f) * sc18), 262143u);
            k18[j] = valid ? (int)kk : -1;
            __hip_atomic_fetch_add(hist + (valid ? (kk >> 9) : (unsigned)(512 + lane)), 1u, __ATOMIC_RELAXED, __HIP_MEMORY_SCOPE_WORKGROUP);
        }
        LDS_WAIT();
        int B1, cab1, n1; hist_find(hist, lane, 256, B1, cab1, n1);
        LDS_WAIT();
        ((LAS u32x4*)hist)[2 * lane] = (u32x4){0u, 0u, 0u, 0u}; ((LAS u32x4*)hist)[2 * lane + 1] = (u32x4){0u, 0u, 0u, 0u};
        LDS_WAIT();
#pragma unroll
        for (int j = 0; j < NJ; ++j) __hip_atomic_fetch_add(hist + (((k18[j] >> 9) == B1) ? (unsigned)(k18[j] & 511) : (unsigned)(512 + lane)), 1u, __ATOMIC_RELAXED, __HIP_MEMORY_SCOPE_WORKGROUP);
        LDS_WAIT();
        int B2, cab2, n2; hist_find(hist, lane, 256 - cab1, B2, cab2, n2);
        LDS_WAIT();
        const int kstar = (B1 << 9) | B2, rr = 256 - cab1 - cab2;
        if (rr == n2) {
            fast = true;
#pragma unroll
            for (int j = 0; j < NJ; ++j) { const u64 w = __ballot(k18[j] >= kstar); if (lane == j) myword = w; }
        } else {
            if (n2 > 8) {
                float bmin = INFINITY, bmax = -INFINITY;
#pragma unroll
                for (int j = 0; j < NJ; ++j) { const bool inb = (k18[j] == kstar); bmin = fminf(bmin, inb ? f[j] : INFINITY); bmax = fmaxf(bmax, inb ? f[j] : -INFINITY); }
#pragma unroll
                for (int off = 32; off; off >>= 1) { bmin = fminf(bmin, __shfl_xor(bmin, off)); bmax = fmaxf(bmax, __shfl_xor(bmax, off)); }
                if (__builtin_amdgcn_readfirstlane((int)(bmin == bmax))) {
                    fast = true; int need = rr;
#pragma unroll
                    for (int j = 0; j < NJ; ++j) {
                        u64 w = __ballot(k18[j] > kstar);
                        if (need > 0) {
                            u64 eq = __ballot(k18[j] == kstar); const int c = __popcll(eq);
                            if (c <= need) { w |= eq; need -= c; }
                            else { while (need > 0) { const u64 low = eq & (~eq + 1ull); w |= low; eq ^= low; --need; } }
                        }
                        if (lane == j) myword = w;
                    }
                }
            }
            if (!fast && n2 <= 64) {
                fast = true;
                int base = 0;
#pragma unroll
                for (int j = 0; j < NJ; ++j) {
                    const bool inb = (k18[j] == kstar); const u64 m = __ballot(inb);
                    if (m) {
                        if (inb) { const int pos = base + (int)__builtin_amdgcn_mbcnt_hi((unsigned)(m >> 32), __builtin_amdgcn_mbcnt_lo((unsigned)m, 0u)); hist[pos] = f2ord(f[j]); hist[64 + pos] = (unsigned)(j * 64 + lane); }
                        base += __popcll(m);
                    }
                }
                LDS_WAIT();
                const unsigned cu = (lane < n2) ? hist[lane] : 0u; const int ck = (lane < n2) ? (int)hist[64 + lane] : 0;
                LDS_WAIT();
                int rank = 0;
                for (int k = 0; k < n2; ++k) { const unsigned x = (unsigned)__builtin_amdgcn_readlane((int)cu, k); rank += (x > cu || (x == cu && k < lane)) ? 1 : 0; }
                const u64 selm = __ballot((lane < n2) && (rank < rr));
#pragma unroll
                for (int j = 0; j < NJ; ++j) { const u64 w = __ballot(k18[j] > kstar); if (lane == j) myword = w; }
                for (int k = 0; k < n2; ++k) if ((selm >> k) & 1ull) { const int key = __builtin_amdgcn_readlane(ck, k); if (lane == (key >> 6)) myword |= 1ull << (key & 63); }
            }
        }
    }
    if (!fast) {
        PROF_T(fb0);
#ifdef PROBE_SEC
        LAS unsigned char* lds = (LAS unsigned char*)hist - LDS_HIST;
#endif
        unsigned u[NJ]; unsigned umax = 0u;
#pragma unroll
        for (int j = 0; j < NJ; ++j) { u[j] = (k18[j] >= 0) ? f2ord(f[j]) : 0u; umax = max(umax, u[j]); }
#pragma unroll
        for (int off = 32; off; off >>= 1) umax = max(umax, (unsigned)__shfl_xor((int)umax, off));
        const unsigned hi_u = (unsigned)__builtin_amdgcn_readfirstlane((int)umax);
        unsigned prefix = 0u; int cge = t + 1;
        for (int bit = 31; bit >= 0; --bit) {
            const unsigned cand = prefix | (1u << bit);
            if (cand > hi_u) continue;
            int cnt = 0;
#pragma unroll
            for (int j = 0; j < NJ; ++j) cnt += __popcll(__ballot(u[j] >= cand));
            if (cnt >= 256) { prefix = cand; cge = cnt; }
            if (cnt == 256) break;
        }
        int cgt = 0;
#pragma unroll
        for (int j = 0; j < NJ; ++j) cgt += __popcll(__ballot(u[j] > prefix));
        int need = 256 - cgt;
#pragma unroll
        for (int j = 0; j < NJ; ++j) {
            u64 w = __ballot(u[j] > prefix); u64 eq = __ballot(u[j] == prefix); const int c = __popcll(eq);
            if (c <= need) { w |= eq; need -= c; }
            else { while (need > 0) { const u64 low = eq & (~eq + 1ull); w |= low; eq ^= low; --need; } }
            if (lane == j) myword = w;
        }
        PROF_T(fb1); PROF_ACC(11, fb0, fb1);
    }
    return myword;
}
__device__ __forceinline__ bool sel_item(const Params& p, int b, int qt, LAS unsigned char* lds, int tid, int wave, int lane, unsigned* ctr) {
    u64* mask = (u64*)(p.ws + WS_MASK);
    const int t0 = qt * 16;
    if (t0 < 256) {
        const int n = tid >> 5, j = tid & 31, t = t0 + n, lo = j * 64; u64 w;
        if (t >= lo + 63) w = ~0ull; else if (t < lo) w = 0ull; else w = (2ull << (t - lo)) - 1ull;
        mask[((size_t)b * SEQ + t) * 32 + j] = w;
        return false;
    }
    PROF_T(st0);
    const bf16_t* pb = (const bf16_t*)(p.ws + WS_PROJ) + (size_t)b * SEQ * NP;
    LAS float* sc = (LAS float*)lds;
    const int n = lane & 15, g = lane >> 4;
    {
        bf16x8 bq[4][2]; float iw[4];
        const bf16_t* qrow = pb + (size_t)(t0 + n) * NP;
#pragma unroll
        for (int h = 0; h < 4; ++h) {
#pragma unroll
            for (int ks = 0; ks < 2; ++ks) bq[h][ks] = as_bf8(*(const u32x4*)(qrow + C_IQ + h * 64 + ks * 32 + g * 8));
        }
        { const u32x2 w = *(const u32x2*)(qrow + C_IW); iw[0] = 0.5f * bf_lo(w.x); iw[1] = 0.5f * bf_hi(w.x); iw[2] = 0.5f * bf_lo(w.y); iw[3] = 0.5f * bf_hi(w.y); }
        const int nkt = qt + 1;
        for (int kt = wave; kt < nkt; kt += 8) {
            const bf16_t* krow = pb + (size_t)(kt * 16 + n) * NP + C_IK + g * 8;
            const bf16x8 a0 = as_bf8(*(const u32x4*)krow), a1 = as_bf8(*(const u32x4*)(krow + 32));
            f32x4 s = {0.f, 0.f, 0.f, 0.f};
#pragma unroll
            for (int h = 0; h < 4; ++h) {
                f32x4 c = {0.f, 0.f, 0.f, 0.f};
                c = mfma16(a0, bq[h][0], c); c = mfma16(a1, bq[h][1], c);
#pragma unroll
                for (int r = 0; r < 4; ++r) s[r] += iw[h] * fmaxf(c[r], 0.f);
            }
            *(LAS f32x4*)(sc + n * 2052 + kt * 16 + 4 * g) = s;
        }
    }
    PROF_T(st1); PROF_ACC(5, st0, st1);
    LDS_BARRIER();
    PROF_T(st2); PROF_ACC(6, st1, st2);
    unsigned nxt = 0u;
    if (tid == 448) nxt = atomicAdd(ctr, 1u);
#pragma unroll 1
    for (int qi = 0; qi < 2; ++qi) {
        const int nq = wave + 8 * qi, t = t0 + nq, nw = (t >> 6) + 1; const LAS float* srow = sc + nq * 2052;
        u64 w;
        LAS unsigned* hist = (LAS unsigned*)(lds + LDS_HIST + wave * 2304);
        if (nw <= 8) w = select_row<8>(srow, t, lane, hist);
        else if (nw <= 16) w = select_row<16>(srow, t, lane, hist);
        else if (nw <= 24) w = select_row<24>(srow, t, lane, hist);
        else w = select_row<32>(srow, t, lane, hist);
        if (lane < 32) mask[((size_t)b * SEQ + t) * 32 + lane] = w;
    }
    if (tid == 448) ((volatile LAS unsigned*)(lds + LDS_QUEUE))[0] = nxt;
    PROF_T(st3); PROF_ACC(7, st2, st3);
    return true;
}

__device__ __forceinline__ void gla_seq(const Params& p, int l, int b, int h, LAS unsigned char* lds, int tid, int wave, int lane) {
    LAS bf16_t* bq = (LAS bf16_t*)(lds);
    LAS bf16_t* bk = (LAS bf16_t*)(lds + 9216);
    LAS bf16_t* bkdT = (LAS bf16_t*)(lds + 18432);
    LAS bf16_t* bvT = (LAS bf16_t*)(lds + 25344);
    LAS bf16_t* bST = (LAS bf16_t*)(lds + 39168);
    LAS float* fb = (LAS float*)(lds + 52992);
    LAS float* fs = (LAS float*)(lds + 65280);
    LAS float* fo = (LAS float*)(lds + 66816);
    for (int i = tid; i < 13248; i += 512) ((LAS unsigned*)lds)[i] = 0u;
    __syncthreads();
    const bf16_t* proj = (const bf16_t*)(p.ws + WS_PROJ); bf16_t* mix = (bf16_t*)(p.ws + WS_MIX);
    const size_t rowbase = (size_t)b * SEQ;
    const int n = lane & 15, g = lane >> 4, t_e = tid >> 3, dc = tid & 7;
    f32x4 st[3];
#pragma unroll
    for (int k = 0; k < 3; ++k) st[k] = (f32x4){0.f, 0.f, 0.f, 0.f};
    const int gtt = wave & 3, jt0 = (wave < 4) ? 0 : 2, njt = (wave < 4) ? 2 : 1;
    bf16x8 wgB[2]; float gbias[2];
#pragma unroll
    for (int q = 0; q < 2; ++q) {
        float wv[8];
#pragma unroll
        for (int i = 0; i < 8; ++i) wv[i] = (g < 2 && q < njt) ? p.wgate[((size_t)l * 16 + 8 * g + i) * 192 + h * 48 + 16 * (jt0 + q) + n] : 0.f;
        wgB[q] = as_bf8(pack8(wv)); gbias[q] = (q < njt) ? p.bgate[l * 192 + h * 48 + 16 * (jt0 + q) + n] : 0.f;
    }
    u32x4 rz = {0, 0, 0, 0}, rq = {0, 0, 0, 0}, rk = {0, 0, 0, 0}, rv0 = {0, 0, 0, 0}, rv1 = {0, 0, 0, 0};
    u32x2 rg[3] = {{0, 0}, {0, 0}, {0, 0}}, rgn[3] = {{0, 0}, {0, 0}, {0, 0}};
    float gain12[12];
#pragma unroll
    for (int i = 0; i < 12; ++i) gain12[i] = p.ogain[l * 96 + dc * 12 + i];
    const int v0t = tid / 12, v0e = tid % 12, v1t = (tid + 512) / 12, v1e = (tid + 512) % 12;
#define GLA_LOAD(cc) do { const size_t R_ = rowbase + 64 * (size_t)(cc); const bf16_t* rp_ = proj + (R_ + t_e) * NP; \
        if (dc < 6) { rq = *(const u32x4*)(rp_ + C_GQ + h * 48 + dc * 8); rk = *(const u32x4*)(rp_ + C_GK + h * 48 + dc * 8); } \
        rz = (g < 2) ? *(const u32x4*)(proj + (R_ + 16 * gtt + n) * NP + C_GGR + 8 * g) : (u32x4){0u, 0u, 0u, 0u}; \
        rv0 = *(const u32x4*)(proj + (R_ + v0t) * NP + C_GV + h * 96 + v0e * 8); \
        if (tid < 256) rv1 = *(const u32x4*)(proj + (R_ + v1t) * NP + C_GV + h * 96 + v1e * 8); \
        rgn[0] = *(const u32x2*)(rp_ + C_GZ + h * 96 + dc * 12); rgn[1] = *(const u32x2*)(rp_ + C_GZ + h * 96 + dc * 12 + 4); rgn[2] = *(const u32x2*)(rp_ + C_GZ + h * 96 + dc * 12 + 8); } while (0)
    GLA_LOAD(0);
#pragma unroll 1
    for (int c = 0; c < 32; ++c) {
        const size_t R0 = rowbase + 64 * (size_t)c;
        rg[0] = rgn[0]; rg[1] = rgn[1]; rg[2] = rgn[2];
#pragma unroll
        for (int q = 0; q < 2; ++q) {
            if (q < njt) {
                f32x4 zc = {0.f, 0.f, 0.f, 0.f};
                zc = mfma16(as_bf8(rz), wgB[q], zc);
#pragma unroll
                for (int r = 0; r < 4; ++r) { const float x = zc[r] + gbias[q]; const float ls = fminf(x, 0.f) - __logf(1.0f + __expf(-fabsf(x))); fb[(16 * gtt + 4 * g + r) * 48 + 16 * (jt0 + q) + n] = ls * 0.0625f; }
            }
        }
        LDS_BARRIER();
        float pre[8]; const int seg = tid / 48, d = tid - seg * 48;
        if (tid < 384) { float run = 0.f;
#pragma unroll
            for (int i = 0; i < 8; ++i) { run += fb[(8 * seg + i) * 48 + d]; pre[i] = run; }
            fs[seg * 48 + d] = run; }
        LDS_BARRIER();
        if (tid < 384) { float off = 0.f;
#pragma unroll
            for (int s = 0; s < 8; ++s) off += (s < seg) ? fs[s * 48 + d] : 0.f;
#pragma unroll
            for (int i = 0; i < 8; ++i) fb[(8 * seg + i) * 48 + d] = pre[i] + off; }
        LDS_BARRIER();
        if (dc < 6) {
            float q[8], k[8], qt[8], kt[8]; unpack8(rq, q); unpack8(rk, k);
#pragma unroll
            for (int i = 0; i < 8; ++i) {
                const float bb = fb[t_e * 48 + dc * 8 + i], bl = fb[63 * 48 + dc * 8 + i];
                qt[i] = q[i] * __expf(bb) * 0.14433756729740643f; kt[i] = k[i] * __expf(-bb);
                const float kd = k[i] * __expf(bl - bb);
                bkdT[(dc * 8 + i) * 72 + t_e] = (bf16_t)(pk2(kd, 0.f) & 0xffffu);
            }
            *(LAS u32x4*)(bq + t_e * 72 + dc * 8) = pack8(qt); *(LAS u32x4*)(bk + t_e * 72 + dc * 8) = pack8(kt);
        }
        {
            const unsigned wv[4] = {rv0.x, rv0.y, rv0.z, rv0.w};
#pragma unroll
            for (int i = 0; i < 4; ++i) { bvT[(v0e * 8 + 2 * i) * 72 + v0t] = (bf16_t)(wv[i] & 0xffffu); bvT[(v0e * 8 + 2 * i + 1) * 72 + v0t] = (bf16_t)(wv[i] >> 16); }
            if (tid < 256) { const unsigned wu[4] = {rv1.x, rv1.y, rv1.z, rv1.w};
#pragma unroll
                for (int i = 0; i < 4; ++i) { bvT[(v1e * 8 + 2 * i) * 72 + v1t] = (bf16_t)(wu[i] & 0xffffu); bvT[(v1e * 8 + 2 * i + 1) * 72 + v1t] = (bf16_t)(wu[i] >> 16); } }
        }
        LDS_BARRIER();
        if (c + 1 < 32) GLA_LOAD(c + 1);
        {
            const int it = wave & 3, eh = wave >> 2;
            bf16x8 qB[2];
#pragma unroll
            for (int ks = 0; ks < 2; ++ks) qB[ks] = as_bf8(*(const LAS u32x4*)(bq + (16 * it + n) * 72 + 32 * ks + 8 * g));
            f32x4 at[4];
#pragma unroll
            for (int jt = 0; jt < 4; ++jt) {
                f32x4 cc = {0.f, 0.f, 0.f, 0.f};
                if (jt <= it) {
                    const bf16x8 a0 = as_bf8(*(const LAS u32x4*)(bk + (16 * jt + n) * 72 + 8 * g)), a1 = as_bf8(*(const LAS u32x4*)(bk + (16 * jt + n) * 72 + 32 + 8 * g));
                    cc = mfma16(a0, qB[0], cc); cc = mfma16(a1, qB[1], cc);
                    if (jt == it) {
#pragma unroll
                        for (int r = 0; r < 4; ++r) if (4 * g + r > n) cc[r] = 0.f;
                    }
                }
                at[jt] = cc;
            }
            bf16x8 pf[2];
#pragma unroll
            for (int s2 = 0; s2 < 2; ++s2) { u32x4 w; w.x = pk2(at[2 * s2][0], at[2 * s2][1]); w.y = pk2(at[2 * s2][2], at[2 * s2][3]); w.z = pk2(at[2 * s2 + 1][0], at[2 * s2 + 1][1]); w.w = pk2(at[2 * s2 + 1][2], at[2 * s2 + 1][3]); pf[s2] = as_bf8(w); }
#pragma unroll
            for (int ei = 0; ei < 3; ++ei) {
                const int et = 3 * eh + ei; f32x4 oa = {0.f, 0.f, 0.f, 0.f};
#pragma unroll
                for (int s2 = 0; s2 < 2; ++s2) {
                    const u32x2 lo = *(const LAS u32x2*)(bvT + (16 * et + n) * 72 + 32 * s2 + 4 * g), hi = *(const LAS u32x2*)(bvT + (16 * et + n) * 72 + 32 * s2 + 16 + 4 * g);
                    u32x4 w; w.x = lo.x; w.y = lo.y; w.z = hi.x; w.w = hi.y;
                    oa = mfma16(as_bf8(w), pf[s2], oa);
                }
#pragma unroll
                for (int ks = 0; ks < 2; ++ks) oa = mfma16(as_bf8(*(const LAS u32x4*)(bST + (16 * et + n) * 72 + 32 * ks + 8 * g)), qB[ks], oa);
                *(LAS f32x4*)(fo + (16 * it + n) * 100 + 16 * et + 4 * g) = oa;
            }
#pragma unroll
            for (int kk = 0; kk < 3; ++kk) {
                const int tile = wave + 8 * kk;
                if (tile < 18) {
                    const int et = tile / 3, dtl = tile % 3; const float dec = __expf(fb[63 * 48 + 16 * dtl + n]);
                    f32x4 acc = st[kk] * dec;
#pragma unroll
                    for (int ks = 0; ks < 2; ++ks) acc = mfma16(as_bf8(*(const LAS u32x4*)(bvT + (16 * et + n) * 72 + 32 * ks + 8 * g)), as_bf8(*(const LAS u32x4*)(bkdT + (16 * dtl + n) * 72 + 32 * ks + 8 * g)), acc);
                    st[kk] = acc;
                }
            }
        }
        LDS_BARRIER();
#pragma unroll
        for (int kk = 0; kk < 3; ++kk) {
            const int tile = wave + 8 * kk;
            if (tile < 18) { const int et = tile / 3, dtl = tile % 3;
#pragma unroll
                for (int r = 0; r < 4; ++r) bST[(16 * et + 4 * g + r) * 72 + 16 * dtl + n] = (bf16_t)(pk2(st[kk][r], 0.f) & 0xffffu); }
        }
        {
            const int e0 = dc * 12; float v[12];
#pragma unroll
            for (int j = 0; j < 3; ++j) { const f32x4 x = *(const LAS f32x4*)(fo + t_e * 100 + e0 + 4 * j); v[4 * j] = x[0]; v[4 * j + 1] = x[1]; v[4 * j + 2] = x[2]; v[4 * j + 3] = x[3]; }
            float ss = 0.f;
#pragma unroll
            for (int i = 0; i < 12; ++i) ss += v[i] * v[i];
            ss += __shfl_xor(ss, 1); ss += __shfl_xor(ss, 2); ss += __shfl_xor(ss, 4);
            const float rin = __builtin_amdgcn_rsqf(ss * (1.0f / 96.0f) + 1e-6f);
            bf16_t* op = mix + (R0 + t_e) * DM + 640 + h * 96 + e0;
#pragma unroll
            for (int j = 0; j < 3; ++j) {
                const u32x2 zw = rg[j];
                const float o0 = v[4 * j] * rin * gain12[4 * j] * silu_f(bf_lo(zw.x)), o1 = v[4 * j + 1] * rin * gain12[4 * j + 1] * silu_f(bf_hi(zw.x));
                const float o2 = v[4 * j + 2] * rin * gain12[4 * j + 2] * silu_f(bf_lo(zw.y)), o3 = v[4 * j + 3] * rin * gain12[4 * j + 3] * silu_f(bf_hi(zw.y));
                u32x2 w; w.x = pk2(o0, o1); w.y = pk2(o2, o3); *(u32x2*)(op + 4 * j) = w;
            }
        }
    }
#undef GLA_LOAD
    __syncthreads();
}

__device__ __forceinline__ void att_qk(const LAS bf16_t* Kb, const bf16x8 (&qf)[2][2], f32x4 (&s)[2][4], int n, int g) {
#pragma unroll
    for (int ks = 0; ks < 4; ++ks) {
        const bf16x8 a0 = as_bf8(*(const LAS u32x4*)(Kb + (16 * ks + n) * 72 + 8 * g)), a1 = as_bf8(*(const LAS u32x4*)(Kb + (16 * ks + n) * 72 + 32 + 8 * g));
#pragma unroll
        for (int qi = 0; qi < 2; ++qi) { f32x4 c = {0.f, 0.f, 0.f, 0.f}; c = mfma16(a0, qf[qi][0], c); c = mfma16(a1, qf[qi][1], c); s[qi][ks] = c; }
    }
}
__device__ __forceinline__ void att_softmax_pv(const LAS bf16_t* Vt, const LAS u64* mkrow0, int kt, f32x4 (&s)[2][4], f32x4 (&o)[2][4], float (&lsum)[2], int n, int g) {
    bf16x8 pf[2][2];
#pragma unroll
    for (int qi = 0; qi < 2; ++qi) {
        const u64 mw = mkrow0[qi * 16 * 33 + kt];
        const unsigned mlo = (unsigned)(mw >> (4 * g)), mhi = (unsigned)(mw >> (32 + 4 * g));
        float ps = 0.f;
#pragma unroll
        for (int ks = 0; ks < 4; ++ks)
#pragma unroll
            for (int r = 0; r < 4; ++r) {
                const unsigned word = (ks < 2) ? mlo : mhi; const int idx = 16 * (ks & 1) + r;
                const int mm = ((int)(word << (31 - idx))) >> 31;
                const float pv = __uint_as_float(__float_as_uint(__builtin_amdgcn_exp2f(s[qi][ks][r])) & (unsigned)mm);
                s[qi][ks][r] = pv; ps += pv;
            }
        lsum[qi] += ps;
#pragma unroll
        for (int s2 = 0; s2 < 2; ++s2) { u32x4 w; w.x = pk2(s[qi][2 * s2][0], s[qi][2 * s2][1]); w.y = pk2(s[qi][2 * s2][2], s[qi][2 * s2][3]); w.z = pk2(s[qi][2 * s2 + 1][0], s[qi][2 * s2 + 1][1]); w.w = pk2(s[qi][2 * s2 + 1][2], s[qi][2 * s2 + 1][3]); pf[qi][s2] = as_bf8(w); }
    }
#pragma unroll
    for (int dt = 0; dt < 4; ++dt)
#pragma unroll
        for (int s2 = 0; s2 < 2; ++s2) {
            const u32x2 lo = *(const LAS u32x2*)(Vt + (16 * dt + n) * 72 + 32 * s2 + 4 * g), hi = *(const LAS u32x2*)(Vt + (16 * dt + n) * 72 + 32 * s2 + 16 + 4 * g);
            u32x4 w; w.x = lo.x; w.y = lo.y; w.z = hi.x; w.w = hi.y;
#pragma unroll
            for (int qi = 0; qi < 2; ++qi) o[qi][dt] = mfma16(as_bf8(w), pf[qi][s2], o[qi][dt]);
        }
}
__device__ __forceinline__ void attn_unit(const Params& p, int b, int qb, int h0, LAS unsigned char* lds, int tid, int wave, int lane) {
    LAS u64* mk = (LAS u64*)lds;
    LAS bf16_t* KB = (LAS bf16_t*)(lds + 67584);
    LAS bf16_t* VT = (LAS bf16_t*)(lds + 67584 + 36864);
    const bf16_t* vTg = (const bf16_t*)(p.ws + WS_VT);
    const bf16_t* proj = (const bf16_t*)(p.ws + WS_PROJ); bf16_t* mix = (bf16_t*)(p.ws + WS_MIX); const u64* mask = (const u64*)(p.ws + WS_MASK);
    const int t0 = qb * 256, nt = 4 * qb + 4;
    const size_t rowb = (size_t)b * SEQ;
    __syncthreads();
#pragma unroll 4
    for (int idx = tid; idx < 256 * 32; idx += 512) { const int q = idx >> 5, w = idx & 31; if (w < nt) mk[q * 33 + w] = mask[(rowb + t0 + q) * 32 + w]; }
    __syncthreads();
    const int n = lane & 15, g = lane >> 4;
    const size_t qrow = rowb + t0 + 32 * wave + n;
    const LAS u64* mkrow0 = mk + (32 * wave + n) * 33;
    const int skey = tid >> 3, sc8 = tid & 7;
#pragma unroll 1
    for (int hh = 0; hh < 3; ++hh) {
        const int h = h0 + hh;
        bf16x8 qf[2][2];
#pragma unroll
        for (int qi = 0; qi < 2; ++qi)
#pragma unroll
            for (int ks = 0; ks < 2; ++ks) qf[qi][ks] = as_bf8(*(const u32x4*)(proj + (qrow + 16 * qi) * NP + C_Q + h * 64 + ks * 32 + g * 8));
        f32x4 o[2][4];
#pragma unroll
        for (int qi = 0; qi < 2; ++qi)
#pragma unroll
            for (int dt = 0; dt < 4; ++dt) o[qi][dt] = (f32x4){0.f, 0.f, 0.f, 0.f};
        float lsum[2] = {0.f, 0.f};
        const bf16_t* kp = proj + (rowb + skey) * NP + C_K + h * 64 + sc8 * 8;
        const bf16_t* vp = vTg + ((size_t)(b * 6 + h) * 64 + skey) * SEQ + sc8 * 8;
        const int np = nt >> 1;
        u32x4 rk[2], rv[2];
#pragma unroll
        for (int tt = 0; tt < 2; ++tt) { rk[tt] = *(const u32x4*)(kp + (size_t)tt * 64 * NP); rv[tt] = *(const u32x4*)(vp + tt * 64); }
#define ATT_STAGE(pb) do { _Pragma("unroll") for (int tt_ = 0; tt_ < 2; ++tt_) { *(LAS u32x4*)(KB + ((pb) * 2 + tt_) * 4608 + skey * 72 + sc8 * 8) = rk[tt_]; \
            *(LAS u32x4*)(VT + ((pb) * 2 + tt_) * 4608 + skey * 72 + sc8 * 8) = rv[tt_]; } } while (0)
        ATT_STAGE(0);
        __syncthreads();
#pragma unroll 1
        for (int pp = 0; pp < np; ++pp) {
            if (pp + 1 < np) {
#pragma unroll
                for (int tt = 0; tt < 2; ++tt) { rk[tt] = *(const u32x4*)(kp + (size_t)(2 * pp + 2 + tt) * 64 * NP); rv[tt] = *(const u32x4*)(vp + (2 * pp + 2 + tt) * 64); }
            }
            const LAS bf16_t* Kb = KB + (pp & 1) * 9216; const LAS bf16_t* Vt = VT + (pp & 1) * 9216;
            f32x4 sA[2][4];
            att_qk(Kb, qf, sA, n, g);
            att_softmax_pv(Vt, mkrow0, 2 * pp, sA, o, lsum, n, g);
            att_qk(Kb + 4608, qf, sA, n, g);
            att_softmax_pv(Vt + 4608, mkrow0, 2 * pp + 1, sA, o, lsum, n, g);
            if (pp + 1 < np) ATT_STAGE((pp + 1) & 1);
            LDS_BARRIER();
        }
#undef ATT_STAGE
#pragma unroll
        for (int qi = 0; qi < 2; ++qi) {
            float lt = lsum[qi]; lt += __shfl_xor(lt, 16); lt += __shfl_xor(lt, 32);
            const float inv = __builtin_amdgcn_rcpf(lt);
            const bf16_t* azp = proj + (qrow + 16 * qi) * NP + C_AZ + h * 64 + 4 * g; bf16_t* op = mix + (qrow + 16 * qi) * DM + h * 64 + 4 * g;
#pragma unroll
            for (int dt = 0; dt < 4; ++dt) {
                const u32x2 zw = *(const u32x2*)(azp + 16 * dt);
                const float o0 = o[qi][dt][0] * inv * silu_f(bf_lo(zw.x)), o1 = o[qi][dt][1] * inv * silu_f(bf_hi(zw.x)), o2 = o[qi][dt][2] * inv * silu_f(bf_lo(zw.y)), o3 = o[qi][dt][3] * inv * silu_f(bf_hi(zw.y));
                u32x2 w; w.x = pk2(o0, o1); w.y = pk2(o2, o3); *(u32x2*)(op + 16 * dt) = w;
            }
        }
    }
}

#define XB_TMO      128
#define XB_XCNT(j)  (256  + 64 * (j))
#define XB_XSUB(j)  (1280 + 64 * (j))
#define XB_XGEN(j)  (2304 + 64 * (j))
#define XB_TOP      3328
#define XB_TOPGEN   3392
#define XCD_BAR_WORDS 3456
#define XB_SPIN_CAP (1u << 18)

__device__ __forceinline__ unsigned xb_ld(unsigned* p)              { return __hip_atomic_load(p, __ATOMIC_RELAXED, __HIP_MEMORY_SCOPE_AGENT); }
__device__ __forceinline__ unsigned xb_add(unsigned* p, unsigned v) { return __hip_atomic_fetch_add(p, v, __ATOMIC_RELAXED, __HIP_MEMORY_SCOPE_AGENT); }
__device__ __forceinline__ unsigned xb_xcc_id() { return (unsigned)__builtin_amdgcn_s_getreg((3 << 11) | 20) & 0xFu; }
#define XB_SPIN(cond, bar) do { unsigned _sp = 0; while (cond) { __builtin_amdgcn_s_sleep(1); \
    if ((++_sp & 255u) == 0u) { if (xb_ld(&(bar)[XB_TMO])) break; if (_sp > XB_SPIN_CAP) { atomicAdd(&(bar)[XB_TMO], 1u); break; } } } } while (0)

struct XcdBarrier {
    unsigned* bar; unsigned x;
    volatile LAS unsigned* st;
};

__device__ __forceinline__ XcdBarrier xcd_barrier_post(unsigned* bar, volatile LAS unsigned* st) {
    XcdBarrier b; b.bar = bar; b.x = xb_xcc_id(); b.st = st;
    if (threadIdx.x == 0) (void)xb_add(&bar[XB_XCNT(b.x)], 1u);
    return b;
}
__device__ __forceinline__ void xcd_barrier_complete(unsigned* bar, unsigned x, unsigned& nloc, unsigned& nx) {
    const unsigned G = gridDim.x * gridDim.y * gridDim.z;
    unsigned sum, cnt, mine, sp = 0u;
    for (;;) {
        sum = 0u; cnt = 0u; mine = 0u;
#pragma unroll
        for (unsigned j = 0; j < 16; ++j) { const unsigned c = xb_ld(&bar[XB_XCNT(j)]); sum += c; cnt += (c > 0u) ? 1u : 0u; mine = (j == x) ? c : mine; }
        if (sum == G) break;
        __builtin_amdgcn_s_sleep(1);
        if ((++sp & 255u) == 0u) { if (xb_ld(&bar[XB_TMO])) break; if (sp > XB_SPIN_CAP) { atomicAdd(&bar[XB_TMO], 1u); break; } }
    }
    nloc = mine > 0u ? mine : 1u; nx = cnt > 0u ? cnt : 1u;
}

__device__ __forceinline__ void xcd_barrier(const XcdBarrier& b) {
    asm volatile("s_waitcnt vmcnt(0)" ::: "memory");
    __syncthreads();
    if (threadIdx.x == 0) {
        unsigned* bar = b.bar;
        __builtin_amdgcn_s_waitcnt(0);
        unsigned nloc = b.st[0], nx = b.st[1];
        if (nloc == 0u) { xcd_barrier_complete(bar, b.x, nloc, nx); b.st[0] = nloc; b.st[1] = nx; }
        const unsigned old = xb_add(&bar[XB_XSUB(b.x)], 1u);
        const unsigned gen = old / nloc;
        if (old + 1u == (gen + 1u) * nloc) {
            __builtin_amdgcn_fence(__ATOMIC_RELEASE, "agent");
            asm volatile("s_waitcnt vmcnt(0)" ::: "memory");
            const unsigned og = xb_add(&bar[XB_TOP], 1u);
            const unsigned tg = og / nx;
            if (og + 1u == (tg + 1u) * nx) xb_add(&bar[XB_TOPGEN], 1u);
            else XB_SPIN(xb_ld(&bar[XB_TOPGEN]) == tg, bar);
            __builtin_amdgcn_fence(__ATOMIC_ACQUIRE, "agent");
            xb_add(&bar[XB_XGEN(b.x)], 1u);
            asm volatile("s_waitcnt vmcnt(0)" ::: "memory");
        } else {
            XB_SPIN(xb_ld(&bar[XB_XGEN(b.x)]) == gen, bar);
            __builtin_amdgcn_fence(__ATOMIC_ACQUIRE, "agent");
            asm volatile("s_waitcnt vmcnt(0)" ::: "memory");
        }
    }
    __syncthreads();
}


__global__ void __launch_bounds__(512, 2) mega_fwd(Params pin) {
    extern __shared__ __attribute__((aligned(16))) unsigned char lds_raw[];
    LAS unsigned char* lds = (LAS unsigned char*)lds_raw;
    cg::grid_group grid = cg::this_grid();
#ifdef PROBE_SEC
    if (threadIdx.x == 0) ((volatile LAS unsigned long long*)(lds + LDS_PROF))[0] = 0ull;
#endif
    XcdBarrier xbar; xbar.bar = nullptr; xbar.x = 0; xbar.st = nullptr;
    if (!MULTI_LAUNCH) {
        volatile LAS unsigned* st = (volatile LAS unsigned*)(lds + LDS_XBST);
        if (threadIdx.x == 0) { st[0] = 0u; st[1] = 0u; }
        __syncthreads();
        xbar = xcd_barrier_post((unsigned*)(pin.ws + WS_CTL) + CW_BAR, st);
    }
#pragma unroll 1
    for (int ph = pin.lo; ph < pin.hi; ++ph) {
#ifdef PROBE_SUB
        const int nrep = ((ph > 0 && (ph - 1) % 5 == PROBE_SUB) || (ph == 0 && PROBE_SUB == 5)) ? 2 : 1;
#else
        const int nrep = 1;
#endif
#pragma unroll 1
        for (int rep = 0; rep < nrep; ++rep) {
        int tid = threadIdx.x; asm volatile("" : "+v"(tid));
        Params p = pin; { size_t z_ = 0; asm volatile("" : "+s"(z_)); p.ws = pin.ws + z_; }
        const int lane = tid & 63, wave = __builtin_amdgcn_readfirstlane(tid >> 6);
        const int G = gridDim.x, bid = blockIdx.x;
        const int gw = bid * 8 + wave, ngw = G * 8;
        bf16_t* XB = (bf16_t*)(p.ws + WS_XB); bf16_t* PROJ = (bf16_t*)(p.ws + WS_PROJ); bf16_t* MIX = (bf16_t*)(p.ws + WS_MIX); float* RINV = (float*)(p.ws + WS_RINV);
        if (rep) __syncthreads();
        if (ph == 0) {
            phase_weights(p, lds, gw, ngw, wave, lane);
            phase_prep_x(p, p.x, gw, ngw, lane);
        } else {
            const int l = (ph - 1) / 5, sub = (ph - 1) % 5;
            if (sub == 0) {
                pg8::Gemm gm{XB, (const bf16_t*)(p.ws + WS_WIN) + (size_t)l * NP * DM, T_TOK, NP, DM};
                pg8::StaticOrder S; S.init(T_TOK, NP, G, bid);
                EpiProj E{PROJ, RINV};
                pg8::gemm_phase<EpiProj, pg8::StaticOrder>(lds, gm, S, E, nullptr);
            } else if (sub == 1) {
                { PROF_T(gt0); for (int gi = bid; gi < 128; gi += G) gla_seq(p, l, gi >> 2, gi & 3, lds, tid, wave, lane); PROF_T(gt1); PROF_ACC(9, gt0, gt1); }
#ifdef PROBE_GLA
                for (int gi = bid; gi < 128; gi += G) gla_seq(p, l, gi >> 2, gi & 3, lds, tid, wave, lane);
#endif
#ifdef PROBE_SEL
                { unsigned* ctr2 = (unsigned*)(p.ws + WS_CTL) + 64 * l + 32; volatile LAS unsigned* qw2 = (volatile LAS unsigned*)(lds + LDS_QUEUE);
                  for (;;) { __syncthreads(); if (tid == 0) qw2[0] = atomicAdd(ctr2, 1u); __syncthreads(); const int item = (int)qw2[0]; if (item >= 4096) break; (void)sel_item(p, item & 31, 127 - (item >> 5), lds, tid, wave, lane, ctr2 + 8); } }
#endif
                unsigned* ctr = (unsigned*)(p.ws + WS_CTL) + 64 * l + 16 * rep;
                volatile LAS unsigned* qw = (volatile LAS unsigned*)(lds + LDS_QUEUE);
                bool have = false;
                for (;;) {
                    int tq = tid; asm volatile("" : "+v"(tq));
                    const int lq = tq & 63, wq = __builtin_amdgcn_readfirstlane(tq >> 6);
                    LDS_BARRIER();
                    if (!have) { if (tq == 0) qw[0] = atomicAdd(ctr, 1u); LDS_BARRIER(); }
                    const int item = (int)qw[0];
                    have = false;
                    if (item >= 4096 + 1024 + 256) break;
                    if (item < 4096) have = sel_item(p, item & 31, 127 - (item >> 5), lds, tq, wq, lq, ctr);
                    else if (item < 5120) { if (rep == nrep - 1) qknorm_item(p, l, item - 4096, tq, lds); }
                    else pool_item(p, item - 5120, tq);
                }
            } else if (sub == 2) {
                for (int pj = bid; pj < 256; pj += G) {
                    const int pi = (G == 256) ? ((pj & 7) * 32 + (pj >> 3)) : pj;
                    const int b = pi >> 3, pp = (pi >> 1) & 3, h0 = 3 * (pi & 1);
                    attn_unit(p, b, 7 - pp, h0, lds, tid, wave, lane);
                    attn_unit(p, b, pp, h0, lds, tid, wave, lane);
                }
            } else if (sub == 3) {
                pg8::Gemm gm{MIX, (const bf16_t*)(p.ws + WS_WOUT) + (size_t)l * DM * DM, T_TOK, DM, DM};
                pg8::StaticOrder S; S.init(T_TOK, DM, G, bid);
                if (l == 0) { EpiOut0 E{XB}; pg8::gemm_phase<EpiOut0, pg8::StaticOrder>(lds, gm, S, E, nullptr); }
                else { EpiOut1 E{XB, rep == nrep - 1 ? p.out : (float*)PROJ}; pg8::gemm_phase<EpiOut1, pg8::StaticOrder>(lds, gm, S, E, nullptr); }
            } else {
                if (l == 0) phase_rinv_bf16(p, gw, ngw, lane);
            }
        }
        }
        if (ph + 1 < pin.hi) { if (MULTI_LAUNCH || pin.lo > pin.hi) grid.sync(); else xcd_barrier(xbar); }
    }
#ifdef PROBE_SEC
    if (blockIdx.x == PROBE_BLK && threadIdx.x == 0) {
        const unsigned long long acc = ((volatile LAS unsigned long long*)(lds + LDS_PROF))[0], s0 = clock64();
        while ((unsigned long long)clock64() - s0 < acc) __builtin_amdgcn_s_sleep(8);
    }
#endif
}

extern "C" void kernel_launch(void* const* d_in, const int* in_sizes, int n_in, void* d_out, int out_size, void* d_ws, size_t ws_size, hipStream_t stream) {
    static int grid_blocks = 0;
    if (!grid_blocks) {
        if (n_in != 11 || ws_size < WS_END) { fprintf(stderr, "kernel_launch: unexpected inputs (n_in %d, ws %zu)\n", n_in, ws_size); return; }
        if (hipFuncSetAttribute((const void*)mega_fwd, hipFuncAttributeMaxDynamicSharedMemorySize, LDS_BYTES) != hipSuccess) { fprintf(stderr, "kernel_launch: hipFuncSetAttribute failed\n"); return; }
        int dev = 0, cus = 0, per_cu = 0;
        (void)hipGetDevice(&dev); (void)hipDeviceGetAttribute(&cus, hipDeviceAttributeMultiprocessorCount, dev);
        (void)hipOccupancyMaxActiveBlocksPerMultiprocessor(&per_cu, mega_fwd, 512, LDS_BYTES);
        if (per_cu < 1) { fprintf(stderr, "kernel_launch: occupancy query says 0 blocks per CU\n"); return; }
        grid_blocks = cus * per_cu; if (grid_blocks > 256) grid_blocks = 256;
    }
    Params p{};
    p.x = (const float*)d_in[0]; p.norm_g = (const float*)d_in[1]; p.w_in = (const float*)d_in[2]; p.qg = (const float*)d_in[3]; p.kg = (const float*)d_in[4];
    p.pool_w = (const float*)d_in[5]; p.pool_scale = (const float*)d_in[6]; p.wgate = (const float*)d_in[7]; p.bgate = (const float*)d_in[8]; p.ogain = (const float*)d_in[9];
    p.w_out = (const float*)d_in[10]; p.out = (float*)d_out; p.ws = (unsigned char*)d_ws;
    (void)hipMemsetAsync((char*)d_ws + WS_CTL, 0, CTL_BYTES, stream);
#if MULTI_LAUNCH
    for (int ph = 0; ph < N_PHASES; ++ph) { p.lo = ph; p.hi = ph + 1; hipLaunchKernelGGL(mega_fwd, dim3(grid_blocks), dim3(512), LDS_BYTES, stream, p); }
#else
    p.lo = 0; p.hi = N_PHASES;
    void* args[] = {&p};
    hipError_t e = hipLaunchCooperativeKernel((const void*)mega_fwd, dim3(grid_blocks), dim3(512), args, LDS_BYTES, stream);
    if (e != hipSuccess) fprintf(stderr, "cooperative launch failed: %s (grid %d)\n", hipGetErrorString(e), grid_blocks);
#endif
}
```

```cpp
#include <hip/hip_runtime.h>
#include <hip/hip_cooperative_groups.h>
#include <cstdio>
#include <cstdint>
namespace cg = cooperative_groups;
namespace pg8 {
#define PG8_LAS __attribute__((address_space(3)))
typedef unsigned short bf16_t;
typedef short bf16x8 __attribute__((ext_vector_type(8)));
typedef float f32x4 __attribute__((ext_vector_type(4)));
typedef unsigned u32x4 __attribute__((ext_vector_type(4)));
constexpr int BM = 256, BK = 64, HALF = 128, HTB = HALF * BK * 2  , STAGE_BYTES = 8 * HTB, NXCD = 8, WGM = 8;

__host__ __device__ __forceinline__ int lds_byte(int r, int c) { const int st = (r >> 4) * 2 + (c >> 5), rr = r & 15, cc = c & 31, ob = rr * 64 + cc * 2; return st * 1024 + (ob ^ (((ob >> 9) & 1) << 5)); }
__host__ __device__ __forceinline__ void stage_rc(int b, int& R, int& C) { const int st = b / 1024, sb = b % 1024, swz = sb ^ (((sb >> 9) & 1) << 5); R = (st >> 1) * 16 + swz / 64; C = (st & 1) * 32 + (swz % 64) / 2; }
__host__ __device__ __forceinline__ int perm32(int rho) { const int n = rho >> 4, i = rho & 15; return 8 * (i >> 2) + 4 * n + (i & 3); }

struct Unit { int pm, pn; };
struct Gemm { const bf16_t* A; const bf16_t* Bt; int M, N, K; };

struct StaticOrder {
    int nM, nN, nwg, G, c;
    __host__ __device__ void init(int M, int N, int G_, int c_) { nM = M / BM; nN = N / BM; nwg = nM * nN; G = G_; c = c_; }
    __host__ __device__ bool next(int i, Unit& u) const {
        const long L = (long)i * G + c; if (L >= nwg) return false;
        int wgid = (int)L; { const int q = nwg / NXCD, r = nwg % NXCD, xcd = wgid % NXCD, off = wgid / NXCD; wgid = (xcd < r ? xcd * (q + 1) : r * (q + 1) + (xcd - r) * q) + off; }
        const int nig = WGM * nN, gid = wgid / nig, fm = gid * WGM, gsz = (nM - fm) < WGM ? (nM - fm) : WGM;
        u.pm = fm + ((wgid % nig) % gsz); u.pn = (wgid % nig) / gsz; return true;
    }
    __device__ __forceinline__ void a_ready(const Unit&) const {}
    __device__ __forceinline__ void done(const Unit&) const {}
};
__device__ __forceinline__ unsigned cvt_pk_bf16(float lo, float hi) { unsigned r; asm volatile("v_cvt_pk_bf16_f32 %0, %1, %2" : "=v"(r) : "v"(lo), "v"(hi)); return r; }
template <class Epi, class Sched, bool STAMP = false>
__device__ __forceinline__ void gemm_phase(PG8_LAS unsigned char* lds, const Gemm g, const Sched& S, const Epi& E, unsigned long long* stamps) {
    int tid_l = threadIdx.x; asm volatile("" : "+v"(tid_l));
    const int tid = tid_l, wid = __builtin_amdgcn_readfirstlane(tid >> 6), lane = tid & 63, wr = wid >> 2, wc = wid & 3, fr = lane & 15, fq = lane >> 4;
    const int K = g.K, nt = K / BK;
    int ts_lo = 0, ts_hi = 0, nts = 0; const unsigned long long rt_entry = STAMP ? (unsigned long long)wall_clock64() : 0ull;
#define PG8_STAMP() do { if (STAMP && wid == 0 && nts < 64) { const unsigned long long _c = (unsigned long long)clock64(); \
        ts_lo = (lane == nts) ? (int)(unsigned)_c : ts_lo; ts_hi = (lane == nts) ? (int)(unsigned)(_c >> 32) : ts_hi; ++nts; } } while (0)
    PG8_STAMP();
    unsigned voffA[2], voffB[2];
#pragma unroll
    for (int i = 0; i < 2; ++i) { int R, C; stage_rc(tid * 16 + i * 8192, R, C); const int Rb = Epi::PERM ? ((R & ~31) + perm32(R & 31)) : R;
        voffA[i] = (unsigned)(R * K + C) * 2u; voffB[i] = (unsigned)(Rb * K + C) * 2u; }
    const size_t kstep = (size_t)(BK * 2);
    const size_t hstep = (size_t)HALF * K * 2;
    const size_t tstep = 2 * hstep;
    const unsigned ldsw = (unsigned)wid * 1024u;
    const int aoff = lds_byte(wr * 64 + fr, fq * 8), boff = lds_byte(wc * 32 + fr, fq * 8);
#define PG8_SA(b, h) (((b) * 2 + (h)) * HTB)
#define PG8_SB(b, h) ((4 + (b) * 2 + (h)) * HTB)
#define PG8_STAGE(bufoff, gbase, voff) do { _Pragma("unroll") for (int _i = 0; _i < 2; ++_i) \
        __builtin_amdgcn_global_load_lds((const unsigned*)((const char*)(gbase) + (voff)[_i]), (PG8_LAS unsigned*)(lds + (bufoff) + ldsw + _i * 8192), 16, 0, 0); } while (0)
#define PG8_LDA(dst, b, h) do { _Pragma("unroll") for (int m = 0; m < 4; ++m) _Pragma("unroll") for (int k = 0; k < 2; ++k) dst[m][k] = *(const PG8_LAS bf16x8*)(lds + PG8_SA(b, h) + aoff + m * 2048 + k * 1024); } while (0)
#define PG8_LDB(dst, b, h) do { _Pragma("unroll") for (int n = 0; n < 2; ++n) _Pragma("unroll") for (int k = 0; k < 2; ++k) dst[n][k] = *(const PG8_LAS bf16x8*)(lds + PG8_SB(b, h) + boff + n * 2048 + k * 1024); } while (0)
#define PG8_MMA(ai, bj, At, Bt) do { __builtin_amdgcn_s_setprio(1); _Pragma("unroll") for (int m = 0; m < 4; ++m) _Pragma("unroll") for (int n = 0; n < 2; ++n) _Pragma("unroll") for (int k = 0; k < 2; ++k) \
        acc[ai][bj][m][n] = __builtin_amdgcn_mfma_f32_16x16x32_bf16(Bt[n][k], At[m][k], acc[ai][bj][m][n], 0, 0, 0); __builtin_amdgcn_s_setprio(0); } while (0)
#define PG8_WAIT_V(n) asm volatile("s_waitcnt vmcnt(" #n ")" ::: "memory")
#define PG8_WAIT_L(n) asm volatile("s_waitcnt lgkmcnt(" #n ")" ::: "memory")
#define PG8_BAR __builtin_amdgcn_s_barrier()
#define PG8_SCHED __builtin_amdgcn_sched_barrier(0)
    Unit cur, nxt; int ui = 0;
    if (!S.next(0, cur)) return;
    f32x4 acc[2][2][4][2];
#pragma unroll
    for (int a = 0; a < 2; ++a)
#pragma unroll
        for (int b = 0; b < 2; ++b)
#pragma unroll
            for (int m = 0; m < 4; ++m)
#pragma unroll
                for (int n = 0; n < 2; ++n) acc[a][b][m][n] = (f32x4){0.f, 0.f, 0.f, 0.f};
    bf16x8 At[4][2], B0[2][2], B1[2][2];
    const char* cA = (const char*)g.A + (size_t)cur.pm * tstep; const char* cB = (const char*)g.Bt + (size_t)cur.pn * tstep;
    S.a_ready(cur);
    PG8_STAGE(PG8_SB(0, 0), cB, voffB); PG8_STAGE(PG8_SA(0, 0), cA, voffA); PG8_STAGE(PG8_SB(0, 1), cB + hstep, voffB); PG8_STAGE(PG8_SA(0, 1), cA + hstep, voffA);
    if (wr == 1) PG8_BAR;
    PG8_WAIT_V(4); PG8_BAR;
    PG8_STAGE(PG8_SB(1, 0), cB + kstep, voffB); PG8_STAGE(PG8_SA(1, 0), cA + kstep, voffA); PG8_STAGE(PG8_SB(1, 1), cB + hstep + kstep, voffB);
    PG8_WAIT_V(6); PG8_BAR;
    PG8_STAMP();
    for (;;) {
        const bool has_next = S.next(ui + 1, nxt);
        const char* nA = has_next ? (const char*)g.A + (size_t)nxt.pm * tstep : cA; const char* nB = has_next ? (const char*)g.Bt + (size_t)nxt.pn * tstep : cB;
        for (int t = 0; t < nt; t += 2) {
            const bool last = (t == nt - 2);
            const char* a1 = cA + (size_t)(t + 1) * kstep;
            const char* a2 = last ? nA : cA + (size_t)(t + 2) * kstep; const char* b2 = last ? nB : cB + (size_t)(t + 2) * kstep;
            const char* a3 = a2 + kstep; const char* b3 = b2 + kstep;
            if (last && has_next) S.a_ready(nxt);
            PG8_LDB(B0, 0, 0); PG8_SCHED; PG8_LDA(At, 0, 0); PG8_STAGE(PG8_SA(1, 1), a1 + hstep, voffA);
            PG8_WAIT_L(8); PG8_BAR; PG8_WAIT_L(0); PG8_MMA(0, 0, At, B0); PG8_BAR; PG8_SCHED;
            PG8_LDB(B1, 0, 1); PG8_STAGE(PG8_SB(0, 0), b2, voffB);
            PG8_BAR; PG8_WAIT_L(0); PG8_MMA(0, 1, At, B1); PG8_BAR;
            PG8_LDA(At, 0, 1); PG8_STAGE(PG8_SA(0, 0), a2, voffA);
            PG8_BAR; PG8_WAIT_L(0); PG8_MMA(1, 0, At, B0); PG8_BAR; PG8_SCHED;
            PG8_STAGE(PG8_SB(0, 1), b2 + hstep, voffB);
            PG8_WAIT_V(6); PG8_BAR; PG8_MMA(1, 1, At, B1); PG8_BAR;
            PG8_LDB(B0, 1, 0); PG8_SCHED; PG8_LDA(At, 1, 0); PG8_STAGE(PG8_SA(0, 1), a2 + hstep, voffA);
            PG8_WAIT_L(8); PG8_BAR; PG8_WAIT_L(0); PG8_MMA(0, 0, At, B0); PG8_BAR; PG8_SCHED;
            PG8_LDB(B1, 1, 1); PG8_STAGE(PG8_SB(1, 0), b3, voffB);
            PG8_BAR; PG8_WAIT_L(0); PG8_MMA(0, 1, At, B1); PG8_BAR;
            PG8_LDA(At, 1, 1); PG8_STAGE(PG8_SA(1, 0), a3, voffA);
            PG8_BAR; PG8_WAIT_L(0); PG8_MMA(1, 0, At, B0); PG8_BAR; PG8_SCHED;
            PG8_STAGE(PG8_SB(1, 1), b3 + hstep, voffB);
            PG8_WAIT_V(6); PG8_BAR; PG8_MMA(1, 1, At, B1); PG8_BAR;
        }
        PG8_STAMP();
        if constexpr (!Epi::AFTER_DRAIN) { E(acc, cur, wr, wc, fr, fq); S.done(cur); }
        PG8_STAMP();
        if (!has_next) break;
#pragma unroll
        for (int a = 0; a < 2; ++a)
#pragma unroll
            for (int b = 0; b < 2; ++b)
#pragma unroll
                for (int m = 0; m < 4; ++m)
#pragma unroll
                    for (int n = 0; n < 2; ++n) acc[a][b][m][n] = (f32x4){0.f, 0.f, 0.f, 0.f};
        cur = nxt; cA = nA; cB = nB; ++ui;
    }
    PG8_WAIT_V(0);
    if (wr == 0) PG8_BAR;
    PG8_BAR;
    if constexpr (Epi::AFTER_DRAIN) { E.fused(acc, cur, wr, wc, fr, fq, lds, wid, lane); S.done(cur); }
    PG8_STAMP();
    if (STAMP && wid == 0) { stamps[lane] = lane < nts ? (((unsigned long long)(unsigned)ts_hi << 32) | (unsigned)ts_lo) : 0ull;
        if (lane == 62) stamps[62] = rt_entry; if (lane == 63) stamps[63] = (unsigned long long)wall_clock64(); }
#undef PG8_STAMP
#undef PG8_SA
#undef PG8_SB
#undef PG8_STAGE
#undef PG8_LDA
#undef PG8_LDB
#undef PG8_MMA
#undef PG8_WAIT_V
#undef PG8_WAIT_L
#undef PG8_BAR
#undef PG8_SCHED
}
}
#define LAS __attribute__((address_space(3)))
typedef unsigned short bf16_t;
typedef short bf16x8 __attribute__((ext_vector_type(8)));
typedef float f32x4 __attribute__((ext_vector_type(4)));
typedef unsigned u32x4 __attribute__((ext_vector_type(4)));
typedef unsigned u32x2 __attribute__((ext_vector_type(2)));
typedef unsigned long long u64;

#ifndef MULTI_LAUNCH
#define MULTI_LAUNCH 0
#endif

constexpr int T_TOK = 65536, SEQ = 2048, NBATCH = 32, DM = 1024, NP = 3584, INW = 3540;
constexpr int C_Q = 0, C_K = 384, C_V = 768, C_AZ = 1152, C_IQ = 1536, C_IK = 1792, C_IW = 1856, C_GGR = 1864, C_PU = 1920, C_PZ = 2176,
              C_GQ = 2432, C_GK = 2624, C_GV = 2816, C_GZ = 3200;
constexpr int LDS_BYTES = 150528;
constexpr int LDS_HIST = 131328;
constexpr int LDS_QUEUE = 149760;
constexpr int LDS_XBST = 149824;
constexpr int LDS_PROF = 149888;
constexpr int CW_BAR = 1024;
constexpr int CTL_BYTES = 32768;
constexpr size_t MiB = 1u << 20;
constexpr size_t WS_CTL = 0, WS_WIN = 1 * MiB, WS_WOUT = 16 * MiB, WS_RINV = 20 * MiB, WS_MASK = 24 * MiB, WS_XB = 40 * MiB,
                 WS_MIX = 168 * MiB, WS_PROJ = 296 * MiB, WS_VT = 776 * MiB, WS_END = 824 * MiB;
constexpr int N_PHASES = 10;
constexpr float LOG2E = 1.4426950408889634f;

struct Params {
    const float* x; const float* norm_g; const float* w_in; const float* qg; const float* kg; const float* pool_w; const float* pool_scale;
    const float* wgate; const float* bgate; const float* ogain; const float* w_out; float* out; unsigned char* ws; int lo, hi;
};

__device__ __forceinline__ float bf_lo(unsigned w) { return __uint_as_float(w << 16); }
__device__ __forceinline__ float bf_hi(unsigned w) { return __uint_as_float(w & 0xffff0000u); }
__device__ __forceinline__ unsigned pk2(float lo, float hi) { return pg8::cvt_pk_bf16(lo, hi); }
__device__ __forceinline__ void unpack8(const u32x4 w, float (&f)[8]) {
    f[0] = bf_lo(w.x); f[1] = bf_hi(w.x); f[2] = bf_lo(w.y); f[3] = bf_hi(w.y); f[4] = bf_lo(w.z); f[5] = bf_hi(w.z); f[6] = bf_lo(w.w); f[7] = bf_hi(w.w);
}
__device__ __forceinline__ u32x4 pack8(const float (&f)[8]) { u32x4 w; w.x = pk2(f[0], f[1]); w.y = pk2(f[2], f[3]); w.z = pk2(f[4], f[5]); w.w = pk2(f[6], f[7]); return w; }
__device__ __forceinline__ f32x4 mfma16(bf16x8 a, bf16x8 b, f32x4 c) { return __builtin_amdgcn_mfma_f32_16x16x32_bf16(a, b, c, 0, 0, 0); }
__device__ __forceinline__ bf16x8 as_bf8(u32x4 w) { return __builtin_bit_cast(bf16x8, w); }
__device__ __forceinline__ float silu_f(float z) { return z * __builtin_amdgcn_rcpf(1.0f + __expf(-z)); }
__device__ __forceinline__ float wave_sum(float v) {
#pragma unroll
    for (int o = 1; o < 64; o <<= 1) v += __shfl_xor(v, o);
    return v;
}
#define LDS_WAIT() asm volatile("s_waitcnt lgkmcnt(0)" ::: "memory")
#define LDS_BARRIER() do { asm volatile("s_waitcnt lgkmcnt(0)" ::: "memory"); __builtin_amdgcn_s_barrier(); asm volatile("" ::: "memory"); } while (0)
#ifdef PROBE_SEC
#define PROF_T(v) const unsigned long long v = clock64()
#define PROF_ACC(id, t0v, t1v) do { if ((id) == PROBE_SEC && threadIdx.x == 0 && blockIdx.x == PROBE_BLK) { volatile LAS unsigned long long* pr_ = (volatile LAS unsigned long long*)(lds + LDS_PROF); pr_[0] = pr_[0] + ((t1v) - (t0v)); } } while (0)
#else
#define PROF_T(v) do {} while (0)
#define PROF_ACC(id, t0v, t1v) do {} while (0)
#endif

struct EpiProj {
    static constexpr bool PERM = true, AFTER_DRAIN = false;
    bf16_t* O; const float* rinv;
    __device__ __forceinline__ void operator()(const pg8::f32x4 (&acc)[2][2][4][2], const pg8::Unit& u, int wr, int wc, int fr, int fq) const {
        const int row0 = u.pm * 256 + wr * 64 + fr, col0 = u.pn * 256 + wc * 32 + 8 * fq;
        asm volatile("" ::: "memory");
        float rs[2][4];
#pragma unroll
        for (int ai = 0; ai < 2; ++ai)
#pragma unroll
            for (int m = 0; m < 4; ++m) rs[ai][m] = rinv[row0 + ai * 128 + m * 16];
#pragma unroll
        for (int ai = 0; ai < 2; ++ai)
#pragma unroll
            for (int m = 0; m < 4; ++m) {
                const int row = row0 + ai * 128 + m * 16; const float rsv = rs[ai][m];
                bf16_t* rowp = O + (size_t)row * NP + col0;
#pragma unroll
                for (int bj = 0; bj < 2; ++bj) {
                    const pg8::f32x4 v0 = acc[ai][bj][m][0] * rsv, v1 = acc[ai][bj][m][1] * rsv;
                    u32x4 w; w.x = pk2(v0[0], v0[1]); w.y = pk2(v0[2], v0[3]); w.z = pk2(v1[0], v1[1]); w.w = pk2(v1[2], v1[3]);
                    *(u32x4*)(rowp + bj * 128) = w;
                }
            }
    }
};
struct EpiOut0 {
    static constexpr bool PERM = false, AFTER_DRAIN = false;
    bf16_t* xb;
    __device__ __forceinline__ void operator()(const pg8::f32x4 (&acc)[2][2][4][2], const pg8::Unit& u, int wr, int wc, int fr, int fq) const {
        const int row0 = u.pm * 256 + wr * 64 + fr, col0 = u.pn * 256 + wc * 32 + 4 * fq;
#pragma unroll
        for (int ai = 0; ai < 2; ++ai)
#pragma unroll
            for (int m = 0; m < 4; ++m) {
                if (ai == 0 && m == 0) asm volatile("" ::: "memory");
                const size_t off = (size_t)(row0 + ai * 128 + m * 16) * DM + col0;
#pragma unroll
                for (int bj = 0; bj < 2; ++bj)
#pragma unroll
                    for (int n = 0; n < 2; ++n) {
                        const u32x2 xw = *(const u32x2*)(xb + off + bj * 128 + n * 16);
                        pg8::f32x4 v; v[0] = bf_lo(xw.x); v[1] = bf_hi(xw.x); v[2] = bf_lo(xw.y); v[3] = bf_hi(xw.y);
                        v = v + acc[ai][bj][m][n];
                        u32x2 w; w.x = pk2(v[0], v[1]); w.y = pk2(v[2], v[3]); *(u32x2*)(xb + off + bj * 128 + n * 16) = w;
                    }
            }
    }
};
struct EpiOut1 {
    static constexpr bool PERM = false, AFTER_DRAIN = false;
    const bf16_t* xb; float* out;
    __device__ __forceinline__ void operator()(const pg8::f32x4 (&acc)[2][2][4][2], const pg8::Unit& u, int wr, int wc, int fr, int fq) const {
        const int row0 = u.pm * 256 + wr * 64 + fr, col0 = u.pn * 256 + wc * 32 + 4 * fq;
#pragma unroll
        for (int ai = 0; ai < 2; ++ai)
#pragma unroll
            for (int m = 0; m < 4; ++m) {
                if (ai == 0 && m == 0) asm volatile("" ::: "memory");
                const size_t off = (size_t)(row0 + ai * 128 + m * 16) * DM + col0;
#pragma unroll
                for (int bj = 0; bj < 2; ++bj)
#pragma unroll
                    for (int n = 0; n < 2; ++n) {
                        const u32x2 w = *(const u32x2*)(xb + off + bj * 128 + n * 16);
                        pg8::f32x4 v; v[0] = bf_lo(w.x); v[1] = bf_hi(w.x); v[2] = bf_lo(w.y); v[3] = bf_hi(w.y);
                        *(pg8::f32x4*)(out + off + bj * 128 + n * 16) = v + acc[ai][bj][m][n];
                    }
            }
    }
};

__device__ __forceinline__ float win_eff(const Params& p, int l, int k, int n) {
    const float* W = p.w_in + ((size_t)l * DM + k) * INW;
    if (n < 1860) return W[n];
    if (n < C_PU) return (n >= C_GGR && n < C_GGR + 16) ? W[3140 + (n - C_GGR)] : 0.f;
    if (n < C_PZ) {
        const int gi = (n - C_PU) >> 6, d = (n - C_PU) & 63;
        const float* pw = p.pool_w + ((size_t)(l * 4 + gi) * 64) * 64 + d; const float* wr = W + 1860 + gi * 64; float s = 0.f;
        for (int c = 0; c < 64; ++c) s += wr[c] * pw[c * 64];
        return s * p.pool_scale[l * 256 + gi * 64 + d];
    }
    if (n < C_GQ) return W[2116 + (n - C_PZ)];
    if (n < C_GK) return W[2372 + (n - C_GQ)];
    if (n < C_GV) return W[2564 + (n - C_GK)];
    if (n < C_GZ) return W[2756 + (n - C_GV)];
    return W[3156 + (n - C_GZ)];
}

__device__ __forceinline__ void phase_weights(const Params& p, LAS unsigned char* lds, int gw, int ngw, int wave, int lane) {
    LAS float* scr = (LAS float*)(lds + wave * 8704);
    bf16_t* WIN = (bf16_t*)(p.ws + WS_WIN); bf16_t* WOUT = (bf16_t*)(p.ws + WS_WOUT);
    constexpr int NI_IN = 2 * 16 * 112, NI_OUT = 2 * 16 * 32;
    for (int it = gw; it < NI_IN + NI_OUT; it += ngw) {
        const int nn = lane & 31;
        bf16_t* dst; int k0, n0, ldk = DM;
        if (it < NI_IN) {
            const int l = it / 1792, r = it % 1792, kb = r / 112, nb = r % 112; k0 = 64 * kb; n0 = 32 * nb;
            if (n0 >= C_PU && n0 < C_PZ) {
                const int gi = (n0 - C_PU) >> 6, d = ((n0 - C_PU) & 63) + nn;
                const float* pw = p.pool_w + ((size_t)(l * 4 + gi) * 64) * 64 + d; const float scl = p.pool_scale[l * 256 + gi * 64 + d];
                float pwr[64];
#pragma unroll
                for (int c = 0; c < 64; ++c) pwr[c] = pw[c * 64] * scl;
#pragma unroll 2
                for (int i = 0; i < 32; ++i) {
                    const int kk = 2 * i + (lane >> 5), k = k0 + kk;
                    const f32x4* wr = (const f32x4*)(p.w_in + ((size_t)l * DM + k) * INW + 1860 + gi * 64);
                    float sa = 0.f, sb = 0.f;
#pragma unroll
                    for (int c4 = 0; c4 < 16; c4 += 2) { const f32x4 w0 = wr[c4], w1 = wr[c4 + 1];
                        sa += (w0.x * pwr[4 * c4] + w0.y * pwr[4 * c4 + 1]) + (w0.z * pwr[4 * c4 + 2] + w0.w * pwr[4 * c4 + 3]);
                        sb += (w1.x * pwr[4 * c4 + 4] + w1.y * pwr[4 * c4 + 5]) + (w1.z * pwr[4 * c4 + 6] + w1.w * pwr[4 * c4 + 7]); }
                    scr[kk * 33 + nn] = (sa + sb) * p.norm_g[l * DM + k];
                }
            } else {
#pragma unroll 4
                for (int i = 0; i < 32; ++i) { const int kk = 2 * i + (lane >> 5), k = k0 + kk; scr[kk * 33 + nn] = win_eff(p, l, k, n0 + nn) * p.norm_g[l * DM + k]; }
            }
            dst = WIN + (size_t)l * NP * DM;
        } else {
            const int r0 = it - NI_IN, l = r0 / 512, r = r0 % 512, kb = r / 32, nb = r % 32; k0 = 64 * kb; n0 = 32 * nb;
            const float* W = p.w_out + (size_t)l * DM * DM;
#pragma unroll 4
            for (int i = 0; i < 32; ++i) { const int kk = 2 * i + (lane >> 5), k = k0 + kk; scr[kk * 33 + nn] = W[(size_t)k * DM + n0 + nn]; }
            dst = WOUT + (size_t)l * DM * DM;
        }
        LDS_WAIT();
        const int c = lane & 7;
#pragma unroll
        for (int j = 0; j < 4; ++j) {
            const int n = (lane >> 3) + 8 * j; const LAS float* s = scr + (8 * c) * 33 + n;
            u32x4 o; o.x = pk2(s[0 * 33], s[1 * 33]); o.y = pk2(s[2 * 33], s[3 * 33]); o.z = pk2(s[4 * 33], s[5 * 33]); o.w = pk2(s[6 * 33], s[7 * 33]);
            *(u32x4*)(dst + (size_t)(n0 + n) * ldk + k0 + 8 * c) = o;
        }
        LDS_WAIT();
    }
}
__device__ __forceinline__ void phase_prep_x(const Params& p, const float* src, int gw, int ngw, int lane) {
    bf16_t* xb = (bf16_t*)(p.ws + WS_XB); float* rinv = (float*)(p.ws + WS_RINV);
    for (int m0 = gw * 4; m0 < T_TOK; m0 += ngw * 4) {
        f32x4 v[4][4]; float s[4];
#pragma unroll
        for (int r = 0; r < 4; ++r) { const f32x4* xr = (const f32x4*)(src + (size_t)(m0 + r) * DM) + lane;
#pragma unroll
            for (int j = 0; j < 4; ++j) v[r][j] = xr[64 * j]; }
#pragma unroll
        for (int r = 0; r < 4; ++r) { float a = 0.f;
#pragma unroll
            for (int j = 0; j < 4; ++j) a += (v[r][j].x * v[r][j].x + v[r][j].y * v[r][j].y) + (v[r][j].z * v[r][j].z + v[r][j].w * v[r][j].w);
            s[r] = wave_sum(a); }
#pragma unroll
        for (int r = 0; r < 4; ++r) {
            if (lane == 0) rinv[m0 + r] = __builtin_amdgcn_rsqf(s[r] * (1.0f / DM) + 1e-6f);
            u32x2* o8 = (u32x2*)(xb + (size_t)(m0 + r) * DM) + lane;
#pragma unroll
            for (int j = 0; j < 4; ++j) { u32x2 w; w.x = pk2(v[r][j].x, v[r][j].y); w.y = pk2(v[r][j].z, v[r][j].w); o8[64 * j] = w; }
        }
    }
}

__device__ __forceinline__ void phase_rinv_bf16(const Params& p, int gw, int ngw, int lane) {
    const bf16_t* xb = (const bf16_t*)(p.ws + WS_XB); float* rinv = (float*)(p.ws + WS_RINV);
    for (int m0 = gw * 8; m0 < T_TOK; m0 += ngw * 8) {
        u32x4 v[8][2];
#pragma unroll
        for (int r = 0; r < 8; ++r) { const u32x4* xr = (const u32x4*)(xb + (size_t)(m0 + r) * DM) + lane; v[r][0] = xr[0]; v[r][1] = xr[64]; }
#pragma unroll
        for (int r = 0; r < 8; ++r) {
            float f[8], a = 0.f;
            unpack8(v[r][0], f);
#pragma unroll
            for (int k = 0; k < 8; ++k) a += f[k] * f[k];
            unpack8(v[r][1], f);
#pragma unroll
            for (int k = 0; k < 8; ++k) a += f[k] * f[k];
            a = wave_sum(a);
            if (lane == 0) rinv[m0 + r] = __builtin_amdgcn_rsqf(a * (1.0f / DM) + 1e-6f);
        }
    }
}

__device__ __forceinline__ void qknorm_item(const Params& p, int l, int item, int tid, LAS unsigned char* lds) {
    bf16_t* proj = (bf16_t*)(p.ws + WS_PROJ);
    {
        LAS bf16_t* tv = (LAS bf16_t*)lds;
        bf16_t* vT = (bf16_t*)(p.ws + WS_VT);
        const size_t row0 = (size_t)item * 64; const int b = (int)(row0 >> 11), t0 = (int)(row0 & (SEQ - 1));
#pragma unroll
        for (int i = 0; i < 6; ++i) { const int id = tid + 512 * i, r = id / 48, c8 = id % 48; *(LAS u32x4*)(tv + r * 392 + c8 * 8) = *(const u32x4*)(proj + (row0 + r) * NP + C_V + c8 * 8); }
        LDS_BARRIER();
#pragma unroll
        for (int i = 0; i < 6; ++i) {
            const int id = tid + 512 * i, tc = id / 384, hd = id % 384;
            const LAS bf16_t* src = tv + (8 * tc) * 392 + hd;
            u32x4 w; w.x = (unsigned)src[0] | ((unsigned)src[392] << 16); w.y = (unsigned)src[2 * 392] | ((unsigned)src[3 * 392] << 16);
            w.z = (unsigned)src[4 * 392] | ((unsigned)src[5 * 392] << 16); w.w = (unsigned)src[6 * 392] | ((unsigned)src[7 * 392] << 16);
            *(u32x4*)(vT + ((size_t)b * 384 + hd) * SEQ + t0 + 8 * tc) = w;
        }
    }
    {
        u32x4 wv[12];
#pragma unroll
        for (int i = 0; i < 12; ++i) { const int idx = tid + 512 * i, r = idx / 96, ch = idx % 96; wv[i] = *(const u32x4*)(proj + ((size_t)item * 64 + r) * NP + ch * 8); }
#pragma unroll
        for (int i = 0; i < 12; ++i) {
            const int idx = tid + 512 * i, ch = idx % 96;
            float f[8]; unpack8(wv[i], f);
            float ss = 0.f;
#pragma unroll
            for (int k = 0; k < 8; ++k) ss += f[k] * f[k];
            ss += __shfl_xor(ss, 1); ss += __shfl_xor(ss, 2); ss += __shfl_xor(ss, 4);
            const float rn = __builtin_amdgcn_rsqf(ss * (1.0f / 64.0f) + 1e-6f);
            const bool isq = ch < 48; const float* gp = (isq ? p.qg : p.kg) + l * 64 + (ch & 7) * 8; const float sc = isq ? (0.125f * LOG2E) * rn : rn;
#pragma unroll
            for (int k = 0; k < 8; ++k) f[k] = f[k] * sc * gp[k];
            wv[i] = pack8(f);
        }
#pragma unroll
        for (int i = 0; i < 12; ++i) { const int idx = tid + 512 * i, r = idx / 96, ch = idx % 96; *(u32x4*)(proj + ((size_t)item * 64 + r) * NP + ch * 8) = wv[i]; }
    }
}
__device__ __forceinline__ void pool_item(const Params& p, int item, int tid) {
    const bf16_t* proj = (const bf16_t*)(p.ws + WS_PROJ); bf16_t* mix = (bf16_t*)(p.ws + WS_MIX);
    const int ch = tid & 31, rb = tid >> 5; const size_t R0 = (size_t)item * 256 + rb * 16; const int t0r = (int)(R0 & (SEQ - 1));
    const int w = 2 << (ch >> 3);
    const bf16_t* up = proj + R0 * NP + C_PU + ch * 8; const bf16_t* zp = proj + R0 * NP + C_PZ + ch * 8;
    float acc[8], f[8], g[8];
#pragma unroll
    for (int k = 0; k < 8; ++k) acc[k] = 0.f;
    for (int j = 1; j < w; ++j) if (t0r - j >= 0) { unpack8(*(const u32x4*)(up - (size_t)j * NP), f);
#pragma unroll
        for (int k = 0; k < 8; ++k) acc[k] += f[k]; }
    u32x4 outv[16];
#pragma unroll
    for (int i = 0; i < 16; ++i) {
        const int t = t0r + i;
        unpack8(*(const u32x4*)(up + (size_t)i * NP), f);
#pragma unroll
        for (int k = 0; k < 8; ++k) acc[k] += f[k];
        const int cnt = (t + 1 < w) ? (t + 1) : w; const float ic = __builtin_amdgcn_rcpf((float)cnt);
        unpack8(*(const u32x4*)(zp + (size_t)i * NP), g);
#pragma unroll
        for (int k = 0; k < 8; ++k) g[k] = (acc[k] * ic - f[k]) * silu_f(g[k]);
        outv[i] = pack8(g);
        if (t - w + 1 >= 0) { unpack8(*(const u32x4*)(up + ((ptrdiff_t)i - (w - 1)) * NP), f);
#pragma unroll
            for (int k = 0; k < 8; ++k) acc[k] -= f[k]; }
    }
#pragma unroll
    for (int i = 0; i < 16; ++i) *(u32x4*)(mix + (R0 + i) * DM + 384 + ch * 8) = outv[i];
}

__device__ __forceinline__ unsigned f2ord(float f) { const unsigned b = __float_as_uint(f); return b ^ ((b >> 31) ? 0xFFFFFFFFu : 0x80000000u); }
__device__ __forceinline__ void hist_find(const LAS unsigned* hist, int lane, int R, int& B, int& cab, int& nB) {
    const u32x4 a = ((const LAS u32x4*)hist)[2 * lane], b = ((const LAS u32x4*)hist)[2 * lane + 1];
    const unsigned h[8] = {a.x, a.y, a.z, a.w, b.x, b.y, b.z, b.w};
    const unsigned s8 = (h[0] + h[1]) + (h[2] + h[3]) + (h[4] + h[5]) + (h[6] + h[7]);
    unsigned v = s8;
#pragma unroll
    for (int off = 1; off < 64; off <<= 1) { const unsigned tt = (unsigned)__shfl_down((int)v, off); v += (lane + off < 64) ? tt : 0u; }
    const int sx = (int)(v - s8);
    const bool mine = (sx < R) && (R <= (int)v);
    int c = sx, Bk = 0, cabk = 0, nk = 0; bool found = false;
#pragma unroll
    for (int k = 7; k >= 0; --k) { if (!found && c + (int)h[k] >= R) { Bk = 8 * lane + k; cabk = c; nk = (int)h[k]; found = true; } c += (int)h[k]; }
    const u64 mm = __ballot(mine); const int src = mm ? (__ffsll((long long)mm) - 1) : 0;
    B = __builtin_amdgcn_readfirstlane(__shfl(Bk, src)); cab = __builtin_amdgcn_readfirstlane(__shfl(cabk, src)); nB = __builtin_amdgcn_readfirstlane(__shfl(nk, src));
}
template <int NJ>
__device__ __forceinline__ u64 select_row(const LAS float* srow, int t, int lane, LAS unsigned* hist) {
    float f[NJ]; int k18[NJ]; float fmx = -INFINITY, fmn = INFINITY;
#pragma unroll
    for (int j = 0; j < NJ; ++j) {
        const int key = j * 64 + lane; const float v = srow[key]; const bool valid = key <= t;
        f[j] = v; k18[j] = valid ? 0 : -1; fmx = fmaxf(fmx, valid ? v : -INFINITY); fmn = fminf(fmn, valid ? v : INFINITY);
    }
#pragma unroll
    for (int off = 32; off; off >>= 1) { fmx = fmaxf(fmx, __shfl_xor(fmx, off)); fmn = fminf(fmn, __shfl_xor(fmn, off)); }
    const float lo_f = __uint_as_float((unsigned)__builtin_amdgcn_readfirstlane((int)__float_as_uint(fmn)));
    const float hi_f = __uint_as_float((unsigned)__builtin_amdgcn_readfirstlane((int)__float_as_uint(fmx)));
    u64 myword = 0ull; bool fast = false;
    if (hi_f > lo_f) {
        const float sc18 = 262143.0f / (hi_f - lo_f);
        ((LAS u32x4*)hist)[2 * lane] = (u32x4){0u, 0u, 0u, 0u}; ((LAS u32x4*)hist)[2 * lane + 1] = (u32x4){0u, 0u, 0u, 0u};
        LDS_WAIT();
#pragma unroll
        for (int j = 0; j < NJ; ++j) {
            const bool valid = k18[j] >= 0; const unsigned kk = min((unsigned)((f[j] - lo_f) * sc18), 262143u);
            k18[j] = valid ? (int)kk : -1;
            __hip_atomic_fetch_add(hist + (valid ? (kk >> 9) : (unsigned)(512 + lane)), 1u, __ATOMIC_RELAXED, __HIP_MEMORY_SCOPE_WORKGROUP);
        }
        LDS_WAIT();
        int B1, cab1, n1; hist_find(hist, lane, 256, B1, cab1, n1);
        LDS_WAIT();
        ((LAS u32x4*)hist)[2 * lane] = (u32x4){0u, 0u, 0u, 0u}; ((LAS u32x4*)hist)[2 * lane + 1] = (u32x4){0u, 0u, 0u, 0u};
        LDS_WAIT();
#pragma unroll
        for (int j = 0; j < NJ; ++j) __hip_atomic_fetch_add(hist + (((k18[j] >> 9) == B1) ? (unsigned)(k18[j] & 511) : (unsigned)(512 + lane)), 1u, __ATOMIC_RELAXED, __HIP_MEMORY_SCOPE_WORKGROUP);
        LDS_WAIT();
        int B2, cab2, n2; hist_find(hist, lane, 256 - cab1, B2, cab2, n2);
        LDS_WAIT();
        const int kstar = (B1 << 9) | B2, rr = 256 - cab1 - cab2;
        if (rr == n2) {
            fast = true;
#pragma unroll
            for (int j = 0; j < NJ; ++j) { const u64 w = __ballot(k18[j] >= kstar); if (lane == j) myword = w; }
        } else {
            if (n2 > 8) {
                float bmin = INFINITY, bmax = -INFINITY;
#pragma unroll
                for (int j = 0; j < NJ; ++j) { const bool inb = (k18[j] == kstar); bmin = fminf(bmin, inb ? f[j] : INFINITY); bmax = fmaxf(bmax, inb ? f[j] : -INFINITY); }
#pragma unroll
                for (int off = 32; off; off >>= 1) { bmin = fminf(bmin, __shfl_xor(bmin, off)); bmax = fmaxf(bmax, __shfl_xor(bmax, off)); }
                if (__builtin_amdgcn_readfirstlane((int)(bmin == bmax))) {
                    fast = true; int need = rr;
#pragma unroll
                    for (int j = 0; j < NJ; ++j) {
                        u64 w = __ballot(k18[j] > kstar);
                        if (need > 0) {
                            u64 eq = __ballot(k18[j] == kstar); const int c = __popcll(eq);
                            if (c <= need) { w |= eq; need -= c; }
                            else { while (need > 0) { const u64 low = eq & (~eq + 1ull); w |= low; eq ^= low; --need; } }
                        }
                        if (lane == j) myword = w;
                    }
                }
            }
            if (!fast && n2 <= 64) {
                fast = true;
                int base = 0;
#pragma unroll
                for (int j = 0; j < NJ; ++j) {
                    const bool inb = (k18[j] == kstar); const u64 m = __ballot(inb);
                    if (m) {
                        if (inb) { const int pos = base + (int)__builtin_amdgcn_mbcnt_hi((unsigned)(m >> 32), __builtin_amdgcn_mbcnt_lo((unsigned)m, 0u)); hist[pos] = f2ord(f[j]); hist[64 + pos] = (unsigned)(j * 64 + lane); }
                        base += __popcll(m);
                    }
                }
                LDS_WAIT();
                const unsigned cu = (lane < n2) ? hist[lane] : 0u; const int ck = (lane < n2) ? (int)hist[64 + lane] : 0;
                LDS_WAIT();
                int rank = 0;
                for (int k = 0; k < n2; ++k) { const unsigned x = (unsigned)__builtin_amdgcn_readlane((int)cu, k); rank += (x > cu || (x == cu && k < lane)) ? 1 : 0; }
                const u64 selm = __ballot((lane < n2) && (rank < rr));
#pragma unroll
                for (int j = 0; j < NJ; ++j) { const u64 w = __ballot(k18[j] > kstar); if (lane == j) myword = w; }
                for (int k = 0; k < n2; ++k) if ((selm >> k) & 1ull) { const int key = __builtin_amdgcn_readlane(ck, k); if (lane == (key >> 6)) myword |= 1ull << (key & 63); }
            }
        }
    }
    if (!fast) {
        PROF_T(fb0);
#ifdef PROBE_SEC
        LAS unsigned char* lds = (LAS unsigned char*)hist - LDS_HIST;
#endif
        unsigned u[NJ]; unsigned umax = 0u;
#pragma unroll
        for (int j = 0; j < NJ; ++j) { u[j] = (k18[j] >= 0) ? f2ord(f[j]) : 0u; umax = max(umax, u[j]); }
#pragma unroll
        for (int off = 32; off; off >>= 1) umax = max(umax, (unsigned)__shfl_xor((int)umax, off));
        const unsigned hi_u = (unsigned)__builtin_amdgcn_readfirstlane((int)umax);
        unsigned prefix = 0u; int cge = t + 1;
        for (int bit = 31; bit >= 0; --bit) {
            const unsigned cand = prefix | (1u << bit);
            if (cand > hi_u) continue;
            int cnt = 0;
#pragma unroll
            for (int j = 0; j < NJ; ++j) cnt += __popcll(__ballot(u[j] >= cand));
            if (cnt >= 256) { prefix = cand; cge = cnt; }
            if (cnt == 256) break;
        }
        int cgt = 0;
#pragma unroll
        for (int j = 0; j < NJ; ++j) cgt += __popcll(__ballot(u[j] > prefix));
        int need = 256 - cgt;
#pragma unroll
        for (int j = 0; j < NJ; ++j) {
            u64 w = __ballot(u[j] > prefix); u64 eq = __ballot(u[j] == prefix); const int c = __popcll(eq);
            if (c <= need) { w |= eq; need -= c; }
            else { while (need > 0) { const u64 low = eq & (~eq + 1ull); w |= low; eq ^= low; --need; } }
            if (lane == j) myword = w;
        }
        PROF_T(fb1); PROF_ACC(11, fb0, fb1);
    }
    return myword;
}
__device__ __forceinline__ bool sel_item(const Params& p, int b, int qt, LAS unsigned char* lds, int tid, int wave, int lane, unsigned* ctr) {
    u64* mask = (u64*)(p.ws + WS_MASK);
    const int t0 = qt * 16;
    if (t0 < 256) {
        const int n = tid >> 5, j = tid & 31, t = t0 + n, lo = j * 64; u64 w;
        if (t >= lo + 63) w = ~0ull; else if (t < lo) w = 0ull; else w = (2ull << (t - lo)) - 1ull;
        mask[((size_t)b * SEQ + t) * 32 + j] = w;
        return false;
    }
    PROF_T(st0);
    const bf16_t* pb = (const bf16_t*)(p.ws + WS_PROJ) + (size_t)b * SEQ * NP;
    LAS float* sc = (LAS float*)lds;
    const int n = lane & 15, g = lane >> 4;
    {
        bf16x8 bq[4][2]; float iw[4];
        const bf16_t* qrow = pb + (size_t)(t0 + n) * NP;
#pragma unroll
        for (int h = 0; h < 4; ++h) {
#pragma unroll
            for (int ks = 0; ks < 2; ++ks) bq[h][ks] = as_bf8(*(const u32x4*)(qrow + C_IQ + h * 64 + ks * 32 + g * 8));
        }
        { const u32x2 w = *(const u32x2*)(qrow + C_IW); iw[0] = 0.5f * bf_lo(w.x); iw[1] = 0.5f * bf_hi(w.x); iw[2] = 0.5f * bf_lo(w.y); iw[3] = 0.5f * bf_hi(w.y); }
        const int nkt = qt + 1;
        for (int kt = wave; kt < nkt; kt += 8) {
            const bf16_t* krow = pb + (size_t)(kt * 16 + n) * NP + C_IK + g * 8;
            const bf16x8 a0 = as_bf8(*(const u32x4*)krow), a1 = as_bf8(*(const u32x4*)(krow + 32));
            f32x4 s = {0.f, 0.f, 0.f, 0.f};
#pragma unroll
            for (int h = 0; h < 4; ++h) {
                f32x4 c = {0.f, 0.f, 0.f, 0.f};
                c = mfma16(a0, bq[h][0], c); c = mfma16(a1, bq[h][1], c);
#pragma unroll
                for (int r = 0; r < 4; ++r) s[r] += iw[h] * fmaxf(c[r], 0.f);
            }
            *(LAS f32x4*)(sc + n * 2052 + kt * 16 + 4 * g) = s;
        }
    }
    PROF_T(st1); PROF_ACC(5, st0, st1);
    LDS_BARRIER();
    PROF_T(st2); PROF_ACC(6, st1, st2);
    unsigned nxt = 0u;
    if (tid == 448) nxt = atomicAdd(ctr, 1u);
#pragma unroll 1
    for (int qi = 0; qi < 2; ++qi) {
        const int nq = wave + 8 * qi, t = t0 + nq, nw = (t >> 6) + 1; const LAS float* srow = sc + nq * 2052;
        u64 w;
        LAS unsigned* hist = (LAS unsigned*)(lds + LDS_HIST + wave * 2304);
        if (nw <= 8) w = select_row<8>(srow, t, lane, hist);
        else if (nw <= 16) w = select_row<16>(srow, t, lane, hist);
        else if (nw <= 24) w = select_row<24>(srow, t, lane, hist);
        else w = select_row<32>(srow, t, lane, hist);
        if (lane < 32) mask[((size_t)b * SEQ + t) * 32 + lane] = w;
    }
    if (tid == 448) ((volatile LAS unsigned*)(lds + LDS_QUEUE))[0] = nxt;
    PROF_T(st3); PROF_ACC(7, st2, st3);
    return true;
}

__device__ __forceinline__ void gla_seq(const Params& p, int l, int b, int h, LAS unsigned char* lds, int tid, int wave, int lane) {
    LAS bf16_t* bq = (LAS bf16_t*)(lds);
    LAS bf16_t* bk = (LAS bf16_t*)(lds + 9216);
    LAS bf16_t* bkdT = (LAS bf16_t*)(lds + 18432);
    LAS bf16_t* bvT = (LAS bf16_t*)(lds + 25344);
    LAS bf16_t* bST = (LAS bf16_t*)(lds + 39168);
    LAS float* fb = (LAS float*)(lds + 52992);
    LAS float* fs = (LAS float*)(lds + 65280);
    LAS float* fo = (LAS float*)(lds + 66816);
    for (int i = tid; i < 13248; i += 512) ((LAS unsigned*)lds)[i] = 0u;
    __syncthreads();
    const bf16_t* proj = (const bf16_t*)(p.ws + WS_PROJ); bf16_t* mix = (bf16_t*)(p.ws + WS_MIX);
    const size_t rowbase = (size_t)b * SEQ;
    const int n = lane & 15, g = lane >> 4, t_e = tid >> 3, dc = tid & 7;
    f32x4 st[3];
#pragma unroll
    for (int k = 0; k < 3; ++k) st[k] = (f32x4){0.f, 0.f, 0.f, 0.f};
    const int gtt = wave & 3, jt0 = (wave < 4) ? 0 : 2, njt = (wave < 4) ? 2 : 1;
    bf16x8 wgB[2]; float gbias[2];
#pragma unroll
    for (int q = 0; q < 2; ++q) {
        float wv[8];
#pragma unroll
        for (int i = 0; i < 8; ++i) wv[i] = (g < 2 && q < njt) ? p.wgate[((size_t)l * 16 + 8 * g + i) * 192 + h * 48 + 16 * (jt0 + q) + n] : 0.f;
        wgB[q] = as_bf8(pack8(wv)); gbias[q] = (q < njt) ? p.bgate[l * 192 + h * 48 + 16 * (jt0 + q) + n] : 0.f;
    }
    u32x4 rz = {0, 0, 0, 0}, rq = {0, 0, 0, 0}, rk = {0, 0, 0, 0}, rv0 = {0, 0, 0, 0}, rv1 = {0, 0, 0, 0};
    u32x2 rg[3] = {{0, 0}, {0, 0}, {0, 0}}, rgn[3] = {{0, 0}, {0, 0}, {0, 0}};
    float gain12[12];
#pragma unroll
    for (int i = 0; i < 12; ++i) gain12[i] = p.ogain[l * 96 + dc * 12 + i];
    const int v0t = tid / 12, v0e = tid % 12, v1t = (tid + 512) / 12, v1e = (tid + 512) % 12;
#define GLA_LOAD(cc) do { const size_t R_ = rowbase + 64 * (size_t)(cc); const bf16_t* rp_ = proj + (R_ + t_e) * NP; \
        if (dc < 6) { rq = *(const u32x4*)(rp_ + C_GQ + h * 48 + dc * 8); rk = *(const u32x4*)(rp_ + C_GK + h * 48 + dc * 8); } \
        rz = (g < 2) ? *(const u32x4*)(proj + (R_ + 16 * gtt + n) * NP + C_GGR + 8 * g) : (u32x4){0u, 0u, 0u, 0u}; \
        rv0 = *(const u32x4*)(proj + (R_ + v0t) * NP + C_GV + h * 96 + v0e * 8); \
        if (tid < 256) rv1 = *(const u32x4*)(proj + (R_ + v1t) * NP + C_GV + h * 96 + v1e * 8); \
        rgn[0] = *(const u32x2*)(rp_ + C_GZ + h * 96 + dc * 12); rgn[1] = *(const u32x2*)(rp_ + C_GZ + h * 96 + dc * 12 + 4); rgn[2] = *(const u32x2*)(rp_ + C_GZ + h * 96 + dc * 12 + 8); } while (0)
    GLA_LOAD(0);
#pragma unroll 1
    for (int c = 0; c < 32; ++c) {
        const size_t R0 = rowbase + 64 * (size_t)c;
        rg[0] = rgn[0]; rg[1] = rgn[1]; rg[2] = rgn[2];
#pragma unroll
        for (int q = 0; q < 2; ++q) {
            if (q < njt) {
                f32x4 zc = {0.f, 0.f, 0.f, 0.f};
                zc = mfma16(as_bf8(rz), wgB[q], zc);
#pragma unroll
                for (int r = 0; r < 4; ++r) { const float x = zc[r] + gbias[q]; const float ls = fminf(x, 0.f) - __logf(1.0f + __expf(-fabsf(x))); fb[(16 * gtt + 4 * g + r) * 48 + 16 * (jt0 + q) + n] = ls * 0.0625f; }
            }
        }
        LDS_BARRIER();
        float pre[8]; const int seg = tid / 48, d = tid - seg * 48;
        if (tid < 384) { float run = 0.f;
#pragma unroll
            for (int i = 0; i < 8; ++i) { run += fb[(8 * seg + i) * 48 + d]; pre[i] = run; }
            fs[seg * 48 + d] = run; }
        LDS_BARRIER();
        if (tid < 384) { float off = 0.f;
#pragma unroll
            for (int s = 0; s < 8; ++s) off += (s < seg) ? fs[s * 48 + d] : 0.f;
#pragma unroll
            for (int i = 0; i < 8; ++i) fb[(8 * seg + i) * 48 + d] = pre[i] + off; }
        LDS_BARRIER();
        if (dc < 6) {
            float q[8], k[8], qt[8], kt[8]; unpack8(rq, q); unpack8(rk, k);
#pragma unroll
            for (int i = 0; i < 8; ++i) {
                const float bb = fb[t_e * 48 + dc * 8 + i], bl = fb[63 * 48 + dc * 8 + i];
                qt[i] = q[i] * __expf(bb) * 0.14433756729740643f; kt[i] = k[i] * __expf(-bb);
                const float kd = k[i] * __expf(bl - bb);
                bkdT[(dc * 8 + i) * 72 + t_e] = (bf16_t)(pk2(kd, 0.f) & 0xffffu);
            }
            *(LAS u32x4*)(bq + t_e * 72 + dc * 8) = pack8(qt); *(LAS u32x4*)(bk + t_e * 72 + dc * 8) = pack8(kt);
        }
        {
            const unsigned wv[4] = {rv0.x, rv0.y, rv0.z, rv0.w};
#pragma unroll
            for (int i = 0; i < 4; ++i) { bvT[(v0e * 8 + 2 * i) * 72 + v0t] = (bf16_t)(wv[i] & 0xffffu); bvT[(v0e * 8 + 2 * i + 1) * 72 + v0t] = (bf16_t)(wv[i] >> 16); }
            if (tid < 256) { const unsigned wu[4] = {rv1.x, rv1.y, rv1.z, rv1.w};
#pragma unroll
                for (int i = 0; i < 4; ++i) { bvT[(v1e * 8 + 2 * i) * 72 + v1t] = (bf16_t)(wu[i] & 0xffffu); bvT[(v1e * 8 + 2 * i + 1) * 72 + v1t] = (bf16_t)(wu[i] >> 16); } }
        }
        LDS_BARRIER();
        if (c + 1 < 32) GLA_LOAD(c + 1);
        {
            const int it = wave & 3, eh = wave >> 2;
            bf16x8 qB[2];
#pragma unroll
            for (int ks = 0; ks < 2; ++ks) qB[ks] = as_bf8(*(const LAS u32x4*)(bq + (16 * it + n) * 72 + 32 * ks + 8 * g));
            f32x4 at[4];
#pragma unroll
            for (int jt = 0; jt < 4; ++jt) {
                f32x4 cc = {0.f, 0.f, 0.f, 0.f};
                if (jt <= it) {
                    const bf16x8 a0 = as_bf8(*(const LAS u32x4*)(bk + (16 * jt + n) * 72 + 8 * g)), a1 = as_bf8(*(const LAS u32x4*)(bk + (16 * jt + n) * 72 + 32 + 8 * g));
                    cc = mfma16(a0, qB[0], cc); cc = mfma16(a1, qB[1], cc);
                    if (jt == it) {
#pragma unroll
                        for (int r = 0; r < 4; ++r) if (4 * g + r > n) cc[r] = 0.f;
                    }
                }
                at[jt] = cc;
            }
            bf16x8 pf[2];
#pragma unroll
            for (int s2 = 0; s2 < 2; ++s2) { u32x4 w; w.x = pk2(at[2 * s2][0], at[2 * s2][1]); w.y = pk2(at[2 * s2][2], at[2 * s2][3]); w.z = pk2(at[2 * s2 + 1][0], at[2 * s2 + 1][1]); w.w = pk2(at[2 * s2 + 1][2], at[2 * s2 + 1][3]); pf[s2] = as_bf8(w); }
#pragma unroll
            for (int ei = 0; ei < 3; ++ei) {
                const int et = 3 * eh + ei; f32x4 oa = {0.f, 0.f, 0.f, 0.f};
#pragma unroll
                for (int s2 = 0; s2 < 2; ++s2) {
                    const u32x2 lo = *(const LAS u32x2*)(bvT + (16 * et + n) * 72 + 32 * s2 + 4 * g), hi = *(const LAS u32x2*)(bvT + (16 * et + n) * 72 + 32 * s2 + 16 + 4 * g);
                    u32x4 w; w.x = lo.x; w.y = lo.y; w.z = hi.x; w.w = hi.y;
                    oa = mfma16(as_bf8(w), pf[s2], oa);
                }
#pragma unroll
                for (int ks = 0; ks < 2; ++ks) oa = mfma16(as_bf8(*(const LAS u32x4*)(bST + (16 * et + n) * 72 + 32 * ks + 8 * g)), qB[ks], oa);
                *(LAS f32x4*)(fo + (16 * it + n) * 100 + 16 * et + 4 * g) = oa;
            }
#pragma unroll
            for (int kk = 0; kk < 3; ++kk) {
                const int tile = wave + 8 * kk;
                if (tile < 18) {
                    const int et = tile / 3, dtl = tile % 3; const float dec = __expf(fb[63 * 48 + 16 * dtl + n]);
                    f32x4 acc = st[kk] * dec;
#pragma unroll
                    for (int ks = 0; ks < 2; ++ks) acc = mfma16(as_bf8(*(const LAS u32x4*)(bvT + (16 * et + n) * 72 + 32 * ks + 8 * g)), as_bf8(*(const LAS u32x4*)(bkdT + (16 * dtl + n) * 72 + 32 * ks + 8 * g)), acc);
                    st[kk] = acc;
                }
            }
        }
        LDS_BARRIER();
#pragma unroll
        for (int kk = 0; kk < 3; ++kk) {
            const int tile = wave + 8 * kk;
            if (tile < 18) { const int et = tile / 3, dtl = tile % 3;
#pragma unroll
                for (int r = 0; r < 4; ++r) bST[(16 * et + 4 * g + r) * 72 + 16 * dtl + n] = (bf16_t)(pk2(st[kk][r], 0.f) & 0xffffu); }
        }
        {
            const int e0 = dc * 12; float v[12];
#pragma unroll
            for (int j = 0; j < 3; ++j) { const f32x4 x = *(const LAS f32x4*)(fo + t_e * 100 + e0 + 4 * j); v[4 * j] = x[0]; v[4 * j + 1] = x[1]; v[4 * j + 2] = x[2]; v[4 * j + 3] = x[3]; }
            float ss = 0.f;
#pragma unroll
            for (int i = 0; i < 12; ++i) ss += v[i] * v[i];
            ss += __shfl_xor(ss, 1); ss += __shfl_xor(ss, 2); ss += __shfl_xor(ss, 4);
            const float rin = __builtin_amdgcn_rsqf(ss * (1.0f / 96.0f) + 1e-6f);
            bf16_t* op = mix + (R0 + t_e) * DM + 640 + h * 96 + e0;
#pragma unroll
            for (int j = 0; j < 3; ++j) {
                const u32x2 zw = rg[j];
                const float o0 = v[4 * j] * rin * gain12[4 * j] * silu_f(bf_lo(zw.x)), o1 = v[4 * j + 1] * rin * gain12[4 * j + 1] * silu_f(bf_hi(zw.x));
                const float o2 = v[4 * j + 2] * rin * gain12[4 * j + 2] * silu_f(bf_lo(zw.y)), o3 = v[4 * j + 3] * rin * gain12[4 * j + 3] * silu_f(bf_hi(zw.y));
                u32x2 w; w.x = pk2(o0, o1); w.y = pk2(o2, o3); *(u32x2*)(op + 4 * j) = w;
            }
        }
    }
#undef GLA_LOAD
    __syncthreads();
}

__device__ __forceinline__ void att_qk(const LAS bf16_t* Kb, const bf16x8 (&qf)[2][2], f32x4 (&s)[2][4], int n, int g) {
#pragma unroll
    for (int ks = 0; ks < 4; ++ks) {
        const bf16x8 a0 = as_bf8(*(const LAS u32x4*)(Kb + (16 * ks + n) * 72 + 8 * g)), a1 = as_bf8(*(const LAS u32x4*)(Kb + (16 * ks + n) * 72 + 32 + 8 * g));
#pragma unroll
        for (int qi = 0; qi < 2; ++qi) { f32x4 c = {0.f, 0.f, 0.f, 0.f}; c = mfma16(a0, qf[qi][0], c); c = mfma16(a1, qf[qi][1], c); s[qi][ks] = c; }
    }
}
__device__ __forceinline__ void att_softmax_pv(const LAS bf16_t* Vt, const LAS u64* mkrow0, int kt, f32x4 (&s)[2][4], f32x4 (&o)[2][4], float (&lsum)[2], int n, int g) {
    bf16x8 pf[2][2];
#pragma unroll
    for (int qi = 0; qi < 2; ++qi) {
        const u64 mw = mkrow0[qi * 16 * 33 + kt];
        const unsigned mlo = (unsigned)(mw >> (4 * g)), mhi = (unsigned)(mw >> (32 + 4 * g));
        float ps = 0.f;
#pragma unroll
        for (int ks = 0; ks < 4; ++ks)
#pragma unroll
            for (int r = 0; r < 4; ++r) {
                const unsigned word = (ks < 2) ? mlo : mhi; const int idx = 16 * (ks & 1) + r;
                const int mm = ((int)(word << (31 - idx))) >> 31;
                const float pv = __uint_as_float(__float_as_uint(__builtin_amdgcn_exp2f(s[qi][ks][r])) & (unsigned)mm);
                s[qi][ks][r] = pv; ps += pv;
            }
        lsum[qi] += ps;
#pragma unroll
        for (int s2 = 0; s2 < 2; ++s2) { u32x4 w; w.x = pk2(s[qi][2 * s2][0], s[qi][2 * s2][1]); w.y = pk2(s[qi][2 * s2][2], s[qi][2 * s2][3]); w.z = pk2(s[qi][2 * s2 + 1][0], s[qi][2 * s2 + 1][1]); w.w = pk2(s[qi][2 * s2 + 1][2], s[qi][2 * s2 + 1][3]); pf[qi][s2] = as_bf8(w); }
    }
#pragma unroll
    for (int dt = 0; dt < 4; ++dt)
#pragma unroll
        for (int s2 = 0; s2 < 2; ++s2) {
            const u32x2 lo = *(const LAS u32x2*)(Vt + (16 * dt + n) * 72 + 32 * s2 + 4 * g), hi = *(const LAS u32x2*)(Vt + (16 * dt + n) * 72 + 32 * s2 + 16 + 4 * g);
            u32x4 w; w.x = lo.x; w.y = lo.y; w.z = hi.x; w.w = hi.y;
#pragma unroll
            for (int qi = 0; qi < 2; ++qi) o[qi][dt] = mfma16(as_bf8(w), pf[qi][s2], o[qi][dt]);
        }
}
__device__ __forceinline__ void attn_unit(const Params& p, int b, int qb, int h0, LAS unsigned char* lds, int tid, int wave, int lane) {
    LAS u64* mk = (LAS u64*)lds;
    LAS bf16_t* KB = (LAS bf16_t*)(lds + 67584);
    LAS bf16_t* VT = (LAS bf16_t*)(lds + 67584 + 36864);
    const bf16_t* vTg = (const bf16_t*)(p.ws + WS_VT);
    const bf16_t* proj = (const bf16_t*)(p.ws + WS_PROJ); bf16_t* mix = (bf16_t*)(p.ws + WS_MIX); const u64* mask = (const u64*)(p.ws + WS_MASK);
    const int t0 = qb * 256, nt = 4 * qb + 4;
    const size_t rowb = (size_t)b * SEQ;
    __syncthreads();
#pragma unroll 4
    for (int idx = tid; idx < 256 * 32; idx += 512) { const int q = idx >> 5, w = idx & 31; if (w < nt) mk[q * 33 + w] = mask[(rowb + t0 + q) * 32 + w]; }
    __syncthreads();
    const int n = lane & 15, g = lane >> 4;
    const size_t qrow = rowb + t0 + 32 * wave + n;
    const LAS u64* mkrow0 = mk + (32 * wave + n) * 33;
    const int skey = tid >> 3, sc8 = tid & 7;
#pragma unroll 1
    for (int hh = 0; hh < 3; ++hh) {
        const int h = h0 + hh;
        bf16x8 qf[2][2];
#pragma unroll
        for (int qi = 0; qi < 2; ++qi)
#pragma unroll
            for (int ks = 0; ks < 2; ++ks) qf[qi][ks] = as_bf8(*(const u32x4*)(proj + (qrow + 16 * qi) * NP + C_Q + h * 64 + ks * 32 + g * 8));
        f32x4 o[2][4];
#pragma unroll
        for (int qi = 0; qi < 2; ++qi)
#pragma unroll
            for (int dt = 0; dt < 4; ++dt) o[qi][dt] = (f32x4){0.f, 0.f, 0.f, 0.f};
        float lsum[2] = {0.f, 0.f};
        const bf16_t* kp = proj + (rowb + skey) * NP + C_K + h * 64 + sc8 * 8;
        const bf16_t* vp = vTg + ((size_t)(b * 6 + h) * 64 + skey) * SEQ + sc8 * 8;
        const int np = nt >> 1;
        u32x4 rk[2], rv[2];
#pragma unroll
        for (int tt = 0; tt < 2; ++tt) { rk[tt] = *(const u32x4*)(kp + (size_t)tt * 64 * NP); rv[tt] = *(const u32x4*)(vp + tt * 64); }
#define ATT_STAGE(pb) do { _Pragma("unroll") for (int tt_ = 0; tt_ < 2; ++tt_) { *(LAS u32x4*)(KB + ((pb) * 2 + tt_) * 4608 + skey * 72 + sc8 * 8) = rk[tt_]; \
            *(LAS u32x4*)(VT + ((pb) * 2 + tt_) * 4608 + skey * 72 + sc8 * 8) = rv[tt_]; } } while (0)
        ATT_STAGE(0);
        __syncthreads();
#pragma unroll 1
        for (int pp = 0; pp < np; ++pp) {
            if (pp + 1 < np) {
#pragma unroll
                for (int tt = 0; tt < 2; ++tt) { rk[tt] = *(const u32x4*)(kp + (size_t)(2 * pp + 2 + tt) * 64 * NP); rv[tt] = *(const u32x4*)(vp + (2 * pp + 2 + tt) * 64); }
            }
            const LAS bf16_t* Kb = KB + (pp & 1) * 9216; const LAS bf16_t* Vt = VT + (pp & 1) * 9216;
            f32x4 sA[2][4];
            att_qk(Kb, qf, sA, n, g);
            att_softmax_pv(Vt, mkrow0, 2 * pp, sA, o, lsum, n, g);
            att_qk(Kb + 4608, qf, sA, n, g);
            att_softmax_pv(Vt + 4608, mkrow0, 2 * pp + 1, sA, o, lsum, n, g);
            if (pp + 1 < np) ATT_STAGE((pp + 1) & 1);
            LDS_BARRIER();
        }
#undef ATT_STAGE
#pragma unroll
        for (int qi = 0; qi < 2; ++qi) {
            float lt = lsum[qi]; lt += __shfl_xor(lt, 16); lt += __shfl_xor(lt, 32);
            const float inv = __builtin_amdgcn_rcpf(lt);
            const bf16_t* azp = proj + (qrow + 16 * qi) * NP + C_AZ + h * 64 + 4 * g; bf16_t* op = mix + (qrow + 16 * qi) * DM + h * 64 + 4 * g;
#pragma unroll
            for (int dt = 0; dt < 4; ++dt) {
                const u32x2 zw = *(const u32x2*)(azp + 16 * dt);
                const float o0 = o[qi][dt][0] * inv * silu_f(bf_lo(zw.x)), o1 = o[qi][dt][1] * inv * silu_f(bf_hi(zw.x)), o2 = o[qi][dt][2] * inv * silu_f(bf_lo(zw.y)), o3 = o[qi][dt][3] * inv * silu_f(bf_hi(zw.y));
                u32x2 w; w.x = pk2(o0, o1); w.y = pk2(o2, o3); *(u32x2*)(op + 16 * dt) = w;
            }
        }
    }
}

#define XB_TMO      128
#define XB_XCNT(j)  (256  + 64 * (j))
#define XB_XSUB(j)  (1280 + 64 * (j))
#define XB_XGEN(j)  (2304 + 64 * (j))
#define XB_TOP      3328
#define XB_TOPGEN   3392
#define XCD_BAR_WORDS 3456
#define XB_SPIN_CAP (1u << 18)

__device__ __forceinline__ unsigned xb_ld(unsigned* p)              { return __hip_atomic_load(p, __ATOMIC_RELAXED, __HIP_MEMORY_SCOPE_AGENT); }
__device__ __forceinline__ unsigned xb_add(unsigned* p, unsigned v) { return __hip_atomic_fetch_add(p, v, __ATOMIC_RELAXED, __HIP_MEMORY_SCOPE_AGENT); }
__device__ __forceinline__ unsigned xb_xcc_id() { return (unsigned)__builtin_amdgcn_s_getreg((3 << 11) | 20) & 0xFu; }
#define XB_SPIN(cond, bar) do { unsigned _sp = 0; while (cond) { __builtin_amdgcn_s_sleep(1); \
    if ((++_sp & 255u) == 0u) { if (xb_ld(&(bar)[XB_TMO])) break; if (_sp > XB_SPIN_CAP) { atomicAdd(&(bar)[XB_TMO], 1u); break; } } } } while (0)

struct XcdBarrier {
    unsigned* bar; unsigned x;
    volatile LAS unsigned* st;
};

__device__ __forceinline__ XcdBarrier xcd_barrier_post(unsigned* bar, volatile LAS unsigned* st) {
    XcdBarrier b; b.bar = bar; b.x = xb_xcc_id(); b.st = st;
    if (threadIdx.x == 0) (void)xb_add(&bar[XB_XCNT(b.x)], 1u);
    return b;
}
__device__ __forceinline__ void xcd_barrier_complete(unsigned* bar, unsigned x, unsigned& nloc, unsigned& nx) {
    const unsigned G = gridDim.x * gridDim.y * gridDim.z;
    unsigned sum, cnt, mine, sp = 0u;
    for (;;) {
        sum = 0u; cnt = 0u; mine = 0u;
#pragma unroll
        for (unsigned j = 0; j < 16; ++j) { const unsigned c = xb_ld(&bar[XB_XCNT(j)]); sum += c; cnt += (c > 0u) ? 1u : 0u; mine = (j == x) ? c : mine; }
        if (sum == G) break;
        __builtin_amdgcn_s_sleep(1);
        if ((++sp & 255u) == 0u) { if (xb_ld(&bar[XB_TMO])) break; if (sp > XB_SPIN_CAP) { atomicAdd(&bar[XB_TMO], 1u); break; } }
    }
    nloc = mine > 0u ? mine : 1u; nx = cnt > 0u ? cnt : 1u;
}

__device__ __forceinline__ void xcd_barrier(const XcdBarrier& b) {
    asm volatile("s_waitcnt vmcnt(0)" ::: "memory");
    __syncthreads();
    if (threadIdx.x == 0) {
        unsigned* bar = b.bar;
        __builtin_amdgcn_s_waitcnt(0);
        unsigned nloc = b.st[0], nx = b.st[1];
        if (nloc == 0u) { xcd_barrier_complete(bar, b.x, nloc, nx); b.st[0] = nloc; b.st[1] = nx; }
        const unsigned old = xb_add(&bar[XB_XSUB(b.x)], 1u);
        const unsigned gen = old / nloc;
        if (old + 1u == (gen + 1u) * nloc) {
            __builtin_amdgcn_fence(__ATOMIC_RELEASE, "agent");
            asm volatile("s_waitcnt vmcnt(0)" ::: "memory");
            const unsigned og = xb_add(&bar[XB_TOP], 1u);
            const unsigned tg = og / nx;
            if (og + 1u == (tg + 1u) * nx) xb_add(&bar[XB_TOPGEN], 1u);
            else XB_SPIN(xb_ld(&bar[XB_TOPGEN]) == tg, bar);
            __builtin_amdgcn_fence(__ATOMIC_ACQUIRE, "agent");
            xb_add(&bar[XB_XGEN(b.x)], 1u);
            asm volatile("s_waitcnt vmcnt(0)" ::: "memory");
        } else {
            XB_SPIN(xb_ld(&bar[XB_XGEN(b.x)]) == gen, bar);
            __builtin_amdgcn_fence(__ATOMIC_ACQUIRE, "agent");
            asm volatile("s_waitcnt vmcnt(0)" ::: "memory");
        }
    }
    __syncthreads();
}


__global__ void __launch_bounds__(512, 2) mega_fwd(Params pin) {
    extern __shared__ __attribute__((aligned(16))) unsigned char lds_raw[];
    LAS unsigned char* lds = (LAS unsigned char*)lds_raw;
    cg::grid_group grid = cg::this_grid();
#ifdef PROBE_SEC
    if (threadIdx.x == 0) ((volatile LAS unsigned long long*)(lds + LDS_PROF))[0] = 0ull;
#endif
    XcdBarrier xbar; xbar.bar = nullptr; xbar.x = 0; xbar.st = nullptr;
    if (!MULTI_LAUNCH) {
        volatile LAS unsigned* st = (volatile LAS unsigned*)(lds + LDS_XBST);
        if (threadIdx.x == 0) { st[0] = 0u; st[1] = 0u; }
        __syncthreads();
        xbar = xcd_barrier_post((unsigned*)(pin.ws + WS_CTL) + CW_BAR, st);
    }
#pragma unroll 1
    for (int ph = pin.lo; ph < pin.hi; ++ph) {
#ifdef PROBE_SUB
        const int nrep = ((ph > 0 && (ph - 1) % 5 == PROBE_SUB) || (ph == 0 && PROBE_SUB == 5)) ? 2 : 1;
#else
        const int nrep = 1;
#endif
#pragma unroll 1
        for (int rep = 0; rep < nrep; ++rep) {
        int tid = threadIdx.x; asm volatile("" : "+v"(tid));
        Params p = pin; { size_t z_ = 0; asm volatile("" : "+s"(z_)); p.ws = pin.ws + z_; }
        const int lane = tid & 63, wave = __builtin_amdgcn_readfirstlane(tid >> 6);
        const int G = gridDim.x, bid = blockIdx.x;
        const int gw = bid * 8 + wave, ngw = G * 8;
        bf16_t* XB = (bf16_t*)(p.ws + WS_XB); bf16_t* PROJ = (bf16_t*)(p.ws + WS_PROJ); bf16_t* MIX = (bf16_t*)(p.ws + WS_MIX); float* RINV = (float*)(p.ws + WS_RINV);
        if (rep) __syncthreads();
        if (ph == 0) {
            phase_weights(p, lds, gw, ngw, wave, lane);
            phase_prep_x(p, p.x, gw, ngw, lane);
        } else {
            const int l = (ph - 1) / 5, sub = (ph - 1) % 5;
            if (sub == 0) {
                pg8::Gemm gm{XB, (const bf16_t*)(p.ws + WS_WIN) + (size_t)l * NP * DM, T_TOK, NP, DM};
                pg8::StaticOrder S; S.init(T_TOK, NP, G, bid);
                EpiProj E{PROJ, RINV};
                pg8::gemm_phase<EpiProj, pg8::StaticOrder>(lds, gm, S, E, nullptr);
            } else if (sub == 1) {
                { PROF_T(gt0); for (int gi = bid; gi < 128; gi += G) gla_seq(p, l, gi >> 2, gi & 3, lds, tid, wave, lane); PROF_T(gt1); PROF_ACC(9, gt0, gt1); }
#ifdef PROBE_GLA
                for (int gi = bid; gi < 128; gi += G) gla_seq(p, l, gi >> 2, gi & 3, lds, tid, wave, lane);
#endif
#ifdef PROBE_SEL
                { unsigned* ctr2 = (unsigned*)(p.ws + WS_CTL) + 64 * l + 32; volatile LAS unsigned* qw2 = (volatile LAS unsigned*)(lds + LDS_QUEUE);
                  for (;;) { __syncthreads(); if (tid == 0) qw2[0] = atomicAdd(ctr2, 1u); __syncthreads(); const int item = (int)qw2[0]; if (item >= 4096) break; (void)sel_item(p, item & 31, 127 - (item >> 5), lds, tid, wave, lane, ctr2 + 8); } }
#endif
                unsigned* ctr = (unsigned*)(p.ws + WS_CTL) + 64 * l + 16 * rep;
                volatile LAS unsigned* qw = (volatile LAS unsigned*)(lds + LDS_QUEUE);
                bool have = false;
                for (;;) {
                    int tq = tid; asm volatile("" : "+v"(tq));
                    const int lq = tq & 63, wq = __builtin_amdgcn_readfirstlane(tq >> 6);
                    LDS_BARRIER();
                    if (!have) { if (tq == 0) qw[0] = atomicAdd(ctr, 1u); LDS_BARRIER(); }
                    const int item = (int)qw[0];
                    have = false;
                    if (item >= 4096 + 1024 + 256) break;
                    if (item < 4096) have = sel_item(p, item & 31, 127 - (item >> 5), lds, tq, wq, lq, ctr);
                    else if (item < 5120) { if (rep == nrep - 1) qknorm_item(p, l, item - 4096, tq, lds); }
                    else pool_item(p, item - 5120, tq);
                }
            } else if (sub == 2) {
                for (int pj = bid; pj < 256; pj += G) {
                    const int pi = (G == 256) ? ((pj & 7) * 32 + (pj >> 3)) : pj;
                    const int b = pi >> 3, pp = (pi >> 1) & 3, h0 = 3 * (pi & 1);
                    attn_unit(p, b, 7 - pp, h0, lds, tid, wave, lane);
                    attn_unit(p, b, pp, h0, lds, tid, wave, lane);
                }
            } else if (sub == 3) {
                pg8::Gemm gm{MIX, (const bf16_t*)(p.ws + WS_WOUT) + (size_t)l * DM * DM, T_TOK, DM, DM};
                pg8::StaticOrder S; S.init(T_TOK, DM, G, bid);
                if (l == 0) { EpiOut0 E{XB}; pg8::gemm_phase<EpiOut0, pg8::StaticOrder>(lds, gm, S, E, nullptr); }
                else { EpiOut1 E{XB, rep == nrep - 1 ? p.out : (float*)PROJ}; pg8::gemm_phase<EpiOut1, pg8::StaticOrder>(lds, gm, S, E, nullptr); }
            } else {
                if (l == 0) phase_rinv_bf16(p, gw, ngw, lane);
            }
        }
        }
        if (ph + 1 < pin.hi) { if (MULTI_LAUNCH || pin.lo > pin.hi) grid.sync(); else xcd_barrier(xbar); }
    }
#ifdef PROBE_SEC
    if (blockIdx.x == PROBE_BLK && threadIdx.x == 0) {
        const unsigned long long acc = ((volatile LAS unsigned long long*)(lds + LDS_PROF))[0], s0 = clock64();
        while ((unsigned long long)clock64() - s0 < acc) __builtin_amdgcn_s_sleep(8);
    }
#endif
}

extern "C" void kernel_launch(void* const* d_in, const int* in_sizes, int n_in, void* d_out, int out_size, void* d_ws, size_t ws_size, hipStream_t stream) {
    static int grid_blocks = 0;
    if (!grid_blocks) {
        if (n_in != 11 || ws_size < WS_END) { fprintf(stderr, "kernel_launch: unexpected inputs (n_in %d, ws %zu)\n", n_in, ws_size); return; }
        if (hipFuncSetAttribute((const void*)mega_fwd, hipFuncAttributeMaxDynamicSharedMemorySize, LDS_BYTES) != hipSuccess) { fprintf(stderr, "kernel_launch: hipFuncSetAttribute failed\n"); return; }
        int dev = 0, cus = 0, per_cu = 0;
        (void)hipGetDevice(&dev); (void)hipDeviceGetAttribute(&cus, hipDeviceAttributeMultiprocessorCount, dev);
        (void)hipOccupancyMaxActiveBlocksPerMultiprocessor(&per_cu, mega_fwd, 512, LDS_BYTES);
        if (per_cu < 1) { fprintf(stderr, "kernel_launch: occupancy query says 0 blocks per CU\n"); return; }
        grid_blocks = cus * per_cu; if (grid_blocks > 256) grid_blocks = 256;
    }
    Params p{};
    p.x = (const float*)d_in[0]; p.norm_g = (const float*)d_in[1]; p.w_in = (const float*)d_in[2]; p.qg = (const float*)d_in[3]; p.kg = (const float*)d_in[4];
    p.pool_w = (const float*)d_in[5]; p.pool_scale = (const float*)d_in[6]; p.wgate = (const float*)d_in[7]; p.bgate = (const float*)d_in[8]; p.ogain = (const float*)d_in[9];
    p.w_out = (const float*)d_in[10]; p.out = (float*)d_out; p.ws = (unsigned char*)d_ws;
    (void)hipMemsetAsync((char*)d_ws + WS_CTL, 0, CTL_BYTES, stream);
#if MULTI_LAUNCH
    for (int ph = 0; ph < N_PHASES; ++ph) { p.lo = ph; p.hi = ph + 1; hipLaunchKernelGGL(mega_fwd, dim3(grid_blocks), dim3(512), LDS_BYTES, stream, p); }
#else
    p.lo = 0; p.hi = N_PHASES;
    void* args[] = {&p};
    hipError_t e = hipLaunchCooperativeKernel((const void*)mega_fwd, dim3(grid_blocks), dim3(512), args, LDS_BYTES, stream);
    if (e != hipSuccess) fprintf(stderr, "cooperative launch failed: %s (grid %d)\n", hipGetErrorString(e), grid_blocks);
#endif
}
```

```cpp
#include <hip/hip_runtime.h>
#include <hip/hip_cooperative_groups.h>
#include <cstdio>
#include <cstdint>
namespace cg = cooperative_groups;
namespace pg8 {
#define PG8_LAS __attribute__((address_space(3)))
typedef unsigned short bf16_t;
typedef short bf16x8 __attribute__((ext_vector_type(8)));
typedef float f32x4 __attribute__((ext_vector_type(4)));
typedef unsigned u32x4 __attribute__((ext_vector_type(4)));
constexpr int BM = 256, BK = 64, HALF = 128, HTB = HALF * BK * 2  , STAGE_BYTES = 8 * HTB, NXCD = 8, WGM = 8;

__host__ __device__ __forceinline__ int lds_byte(int r, int c) { const int st = (r >> 4) * 2 + (c >> 5), rr = r & 15, cc = c & 31, ob = rr * 64 + cc * 2; return st * 1024 + (ob ^ (((ob >> 9) & 1) << 5)); }
__host__ __device__ __forceinline__ void stage_rc(int b, int& R, int& C) { const int st = b / 1024, sb = b % 1024, swz = sb ^ (((sb >> 9) & 1) << 5); R = (st >> 1) * 16 + swz / 64; C = (st & 1) * 32 + (swz % 64) / 2; }
__host__ __device__ __forceinline__ int perm32(int rho) { const int n = rho >> 4, i = rho & 15; return 8 * (i >> 2) + 4 * n + (i & 3); }

struct Unit { int pm, pn; };
struct Gemm { const bf16_t* A; const bf16_t* Bt; int M, N, K; };

struct StaticOrder {
    int nM, nN, nwg, G, c;
    __host__ __device__ void init(int M, int N, int G_, int c_) { nM = M / BM; nN = N / BM; nwg = nM * nN; G = G_; c = c_; }
    __host__ __device__ bool next(int i, Unit& u) const {
        const long L = (long)i * G + c; if (L >= nwg) return false;
        int wgid = (int)L; { const int q = nwg / NXCD, r = nwg % NXCD, xcd = wgid % NXCD, off = wgid / NXCD; wgid = (xcd < r ? xcd * (q + 1) : r * (q + 1) + (xcd - r) * q) + off; }
        const int nig = WGM * nN, gid = wgid / nig, fm = gid * WGM, gsz = (nM - fm) < WGM ? (nM - fm) : WGM;
        u.pm = fm + ((wgid % nig) % gsz); u.pn = (wgid % nig) / gsz; return true;
    }
    __device__ __forceinline__ void a_ready(const Unit&) const {}
    __device__ __forceinline__ void done(const Unit&) const {}
};
__device__ __forceinline__ unsigned cvt_pk_bf16(float lo, float hi) { unsigned r; asm volatile("v_cvt_pk_bf16_f32 %0, %1, %2" : "=v"(r) : "v"(lo), "v"(hi)); return r; }
template <class Epi, class Sched, bool STAMP = false>
__device__ __forceinline__ void gemm_phase(PG8_LAS unsigned char* lds, const Gemm g, const Sched& S, const Epi& E, unsigned long long* stamps) {
    int tid_l = threadIdx.x; asm volatile("" : "+v"(tid_l));
    const int tid = tid_l, wid = __builtin_amdgcn_readfirstlane(tid >> 6), lane = tid & 63, wr = wid >> 2, wc = wid & 3, fr = lane & 15, fq = lane >> 4;
    const int K = g.K, nt = K / BK;
    int ts_lo = 0, ts_hi = 0, nts = 0; const unsigned long long rt_entry = STAMP ? (unsigned long long)wall_clock64() : 0ull;
#define PG8_STAMP() do { if (STAMP && wid == 0 && nts < 64) { const unsigned long long _c = (unsigned long long)clock64(); \
        ts_lo = (lane == nts) ? (int)(unsigned)_c : ts_lo; ts_hi = (lane == nts) ? (int)(unsigned)(_c >> 32) : ts_hi; ++nts; } } while (0)
    PG8_STAMP();
    unsigned voffA[2], voffB[2];
#pragma unroll
    for (int i = 0; i < 2; ++i) { int R, C; stage_rc(tid * 16 + i * 8192, R, C); const int Rb = Epi::PERM ? ((R & ~31) + perm32(R & 31)) : R;
        voffA[i] = (unsigned)(R * K + C) * 2u; voffB[i] = (unsigned)(Rb * K + C) * 2u; }
    const size_t kstep = (size_t)(BK * 2);
    const size_t hstep = (size_t)HALF * K * 2;
    const size_t tstep = 2 * hstep;
    const unsigned ldsw = (unsigned)wid * 1024u;
    const int aoff = lds_byte(wr * 64 + fr, fq * 8), boff = lds_byte(wc * 32 + fr, fq * 8);
#define PG8_SA(b, h) (((b) * 2 + (h)) * HTB)
#define PG8_SB(b, h) ((4 + (b) * 2 + (h)) * HTB)
#define PG8_STAGE(bufoff, gbase, voff) do { _Pragma("unroll") for (int _i = 0; _i < 2; ++_i) \
        __builtin_amdgcn_global_load_lds((const unsigned*)((const char*)(gbase) + (voff)[_i]), (PG8_LAS unsigned*)(lds + (bufoff) + ldsw + _i * 8192), 16, 0, 0); } while (0)
#define PG8_LDA(dst, b, h) do { _Pragma("unroll") for (int m = 0; m < 4; ++m) _Pragma("unroll") for (int k = 0; k < 2; ++k) dst[m][k] = *(const PG8_LAS bf16x8*)(lds + PG8_SA(b, h) + aoff + m * 2048 + k * 1024); } while (0)
#define PG8_LDB(dst, b, h) do { _Pragma("unroll") for (int n = 0; n < 2; ++n) _Pragma("unroll") for (int k = 0; k < 2; ++k) dst[n][k] = *(const PG8_LAS bf16x8*)(lds + PG8_SB(b, h) + boff + n * 2048 + k * 1024); } while (0)
#define PG8_MMA(ai, bj, At, Bt) do { __builtin_amdgcn_s_setprio(1); _Pragma("unroll") for (int m = 0; m < 4; ++m) _Pragma("unroll") for (int n = 0; n < 2; ++n) _Pragma("unroll") for (int k = 0; k < 2; ++k) \
        acc[ai][bj][m][n] = __builtin_amdgcn_mfma_f32_16x16x32_bf16(Bt[n][k], At[m][k], acc[ai][bj][m][n], 0, 0, 0); __builtin_amdgcn_s_setprio(0); } while (0)
#define PG8_WAIT_V(n) asm volatile("s_waitcnt vmcnt(" #n ")" ::: "memory")
#define PG8_WAIT_L(n) asm volatile("s_waitcnt lgkmcnt(" #n ")" ::: "memory")
#define PG8_BAR __builtin_amdgcn_s_barrier()
#define PG8_SCHED __builtin_amdgcn_sched_barrier(0)
    Unit cur, nxt; int ui = 0;
    if (!S.next(0, cur)) return;
    f32x4 acc[2][2][4][2];
#pragma unroll
    for (int a = 0; a < 2; ++a)
#pragma unroll
        for (int b = 0; b < 2; ++b)
#pragma unroll
            for (int m = 0; m < 4; ++m)
#pragma unroll
                for (int n = 0; n < 2; ++n) acc[a][b][m][n] = (f32x4){0.f, 0.f, 0.f, 0.f};
    bf16x8 At[4][2], B0[2][2], B1[2][2];
    const char* cA = (const char*)g.A + (size_t)cur.pm * tstep; const char* cB = (const char*)g.Bt + (size_t)cur.pn * tstep;
    S.a_ready(cur);
    PG8_STAGE(PG8_SB(0, 0), cB, voffB); PG8_STAGE(PG8_SA(0, 0), cA, voffA); PG8_STAGE(PG8_SB(0, 1), cB + hstep, voffB); PG8_STAGE(PG8_SA(0, 1), cA + hstep, voffA);
    if (wr == 1) PG8_BAR;
    PG8_WAIT_V(4); PG8_BAR;
    PG8_STAGE(PG8_SB(1, 0), cB + kstep, voffB); PG8_STAGE(PG8_SA(1, 0), cA + kstep, voffA); PG8_STAGE(PG8_SB(1, 1), cB + hstep + kstep, voffB);
    PG8_WAIT_V(6); PG8_BAR;
    PG8_STAMP();
    for (;;) {
        const bool has_next = S.next(ui + 1, nxt);
        const char* nA = has_next ? (const char*)g.A + (size_t)nxt.pm * tstep : cA; const char* nB = has_next ? (const char*)g.Bt + (size_t)nxt.pn * tstep : cB;
        for (int t = 0; t < nt; t += 2) {
            const bool last = (t == nt - 2);
            const char* a1 = cA + (size_t)(t + 1) * kstep;
            const char* a2 = last ? nA : cA + (size_t)(t + 2) * kstep; const char* b2 = last ? nB : cB + (size_t)(t + 2) * kstep;
            const char* a3 = a2 + kstep; const char* b3 = b2 + kstep;
            if (last && has_next) S.a_ready(nxt);
            PG8_LDB(B0, 0, 0); PG8_SCHED; PG8_LDA(At, 0, 0); PG8_STAGE(PG8_SA(1, 1), a1 + hstep, voffA);
            PG8_WAIT_L(8); PG8_BAR; PG8_WAIT_L(0); PG8_MMA(0, 0, At, B0); PG8_BAR; PG8_SCHED;
            PG8_LDB(B1, 0, 1); PG8_STAGE(PG8_SB(0, 0), b2, voffB);
            PG8_BAR; PG8_WAIT_L(0); PG8_MMA(0, 1, At, B1); PG8_BAR;
            PG8_LDA(At, 0, 1); PG8_STAGE(PG8_SA(0, 0), a2, voffA);
            PG8_BAR; PG8_WAIT_L(0); PG8_MMA(1, 0, At, B0); PG8_BAR; PG8_SCHED;
            PG8_STAGE(PG8_SB(0, 1), b2 + hstep, voffB);
            PG8_WAIT_V(6); PG8_BAR; PG8_MMA(1, 1, At, B1); PG8_BAR;
            PG8_LDB(B0, 1, 0); PG8_SCHED; PG8_LDA(At, 1, 0); PG8_STAGE(PG8_SA(0, 1), a2 + hstep, voffA);
            PG8_WAIT_L(8); PG8_BAR; PG8_WAIT_L(0); PG8_MMA(0, 0, At, B0); PG8_BAR; PG8_SCHED;
            PG8_LDB(B1, 1, 1); PG8_STAGE(PG8_SB(1, 0), b3, voffB);
            PG8_BAR; PG8_WAIT_L(0); PG8_MMA(0, 1, At, B1); PG8_BAR;
            PG8_LDA(At, 1, 1); PG8_STAGE(PG8_SA(1, 0), a3, voffA);
            PG8_BAR; PG8_WAIT_L(0); PG8_MMA(1, 0, At, B0); PG8_BAR; PG8_SCHED;
            PG8_STAGE(PG8_SB(1, 1), b3 + hstep, voffB);
            PG8_WAIT_V(6); PG8_BAR; PG8_MMA(1, 1, At, B1); PG8_BAR;
        }
        PG8_STAMP();
        if constexpr (!Epi::AFTER_DRAIN) { E(acc, cur, wr, wc, fr, fq); S.done(cur); }
        PG8_STAMP();
        if (!has_next) break;
#pragma unroll
        for (int a = 0; a < 2; ++a)
#pragma unroll
            for (int b = 0; b < 2; ++b)
#pragma unroll
                for (int m = 0; m < 4; ++m)
#pragma unroll
                    for (int n = 0; n < 2; ++n) acc[a][b][m][n] = (f32x4){0.f, 0.f, 0.f, 0.f};
        cur = nxt; cA = nA; cB = nB; ++ui;
    }
    PG8_WAIT_V(0);
    if (wr == 0) PG8_BAR;
    PG8_BAR;
    if constexpr (Epi::AFTER_DRAIN) { E.fused(acc, cur, wr, wc, fr, fq, lds, wid, lane); S.done(cur); }
    PG8_STAMP();
    if (STAMP && wid == 0) { stamps[lane] = lane < nts ? (((unsigned long long)(unsigned)ts_hi << 32) | (unsigned)ts_lo) : 0ull;
        if (lane == 62) stamps[62] = rt_entry; if (lane == 63) stamps[63] = (unsigned long long)wall_clock64(); }
#undef PG8_STAMP
#undef PG8_SA
#undef PG8_SB
#undef PG8_STAGE
#undef PG8_LDA
#undef PG8_LDB
#undef PG8_MMA
#undef PG8_WAIT_V
#undef PG8_WAIT_L
#undef PG8_BAR
#undef PG8_SCHED
}
}
#define LAS __attribute__((address_space(3)))
typedef unsigned short bf16_t;
typedef short bf16x8 __attribute__((ext_vector_type(8)));
typedef float f32x4 __attribute__((ext_vector_type(4)));
typedef unsigned u32x4 __attribute__((ext_vector_type(4)));
typedef unsigned u32x2 __attribute__((ext_vector_type(2)));
typedef unsigned long long u64;

#ifndef MULTI_LAUNCH
#define MULTI_LAUNCH 0
#endif

constexpr int T_TOK = 65536, SEQ = 2048, NBATCH = 32, DM = 1024, NP = 3584, INW = 3540;
constexpr int C_Q = 0, C_K = 384, C_V = 768, C_AZ = 1152, C_IQ = 1536, C_IK = 1792, C_IW = 1856, C_GGR = 1864, C_PU = 1920, C_PZ = 2176,
              C_GQ = 2432, C_GK = 2624, C_GV = 2816, C_GZ = 3200;
constexpr int LDS_BYTES = 150528;
constexpr int LDS_HIST = 131328;
constexpr int LDS_QUEUE = 149760;
constexpr int LDS_XBST = 149824;
constexpr int LDS_PROF = 149888;
constexpr int CW_BAR = 1024;
constexpr int CTL_BYTES = 32768;
constexpr size_t MiB = 1u << 20;
constexpr size_t WS_CTL = 0, WS_WIN = 1 * MiB, WS_WOUT = 16 * MiB, WS_RINV = 20 * MiB, WS_MASK = 24 * MiB, WS_XB = 40 * MiB,
                 WS_MIX = 168 * MiB, WS_PROJ = 296 * MiB, WS_VT = 776 * MiB, WS_END = 824 * MiB;
constexpr int N_PHASES = 10;
constexpr float LOG2E = 1.4426950408889634f;

struct Params {
    const float* x; const float* norm_g; const float* w_in; const float* qg; const float* kg; const float* pool_w; const float* pool_scale;
    const float* wgate; const float* bgate; const float* ogain; const float* w_out; float* out; unsigned char* ws; int lo, hi;
};

__device__ __forceinline__ float bf_lo(unsigned w) { return __uint_as_float(w << 16); }
__device__ __forceinline__ float bf_hi(unsigned w) { return __uint_as_float(w & 0xffff0000u); }
__device__ __forceinline__ unsigned pk2(float lo, float hi) { return pg8::cvt_pk_bf16(lo, hi); }
__device__ __forceinline__ void unpack8(const u32x4 w, float (&f)[8]) {
    f[0] = bf_lo(w.x); f[1] = bf_hi(w.x); f[2] = bf_lo(w.y); f[3] = bf_hi(w.y); f[4] = bf_lo(w.z); f[5] = bf_hi(w.z); f[6] = bf_lo(w.w); f[7] = bf_hi(w.w);
}
__device__ __forceinline__ u32x4 pack8(const float (&f)[8]) { u32x4 w; w.x = pk2(f[0], f[1]); w.y = pk2(f[2], f[3]); w.z = pk2(f[4], f[5]); w.w = pk2(f[6], f[7]); return w; }
__device__ __forceinline__ f32x4 mfma16(bf16x8 a, bf16x8 b, f32x4 c) { return __builtin_amdgcn_mfma_f32_16x16x32_bf16(a, b, c, 0, 0, 0); }
__device__ __forceinline__ bf16x8 as_bf8(u32x4 w) { return __builtin_bit_cast(bf16x8, w); }
__device__ __forceinline__ float silu_f(float z) { return z * __builtin_amdgcn_rcpf(1.0f + __expf(-z)); }
__device__ __forceinline__ float wave_sum(float v) {
#pragma unroll
    for (int o = 1; o < 64; o <<= 1) v += __shfl_xor(v, o);
    return v;
}
#define LDS_WAIT() asm volatile("s_waitcnt lgkmcnt(0)" ::: "memory")
#define LDS_BARRIER() do { asm volatile("s_waitcnt lgkmcnt(0)" ::: "memory"); __builtin_amdgcn_s_barrier(); asm volatile("" ::: "memory"); } while (0)
#ifdef PROBE_SEC
#define PROF_T(v) const unsigned long long v = clock64()
#define PROF_ACC(id, t0v, t1v) do { if ((id) == PROBE_SEC && threadIdx.x == 0 && blockIdx.x == PROBE_BLK) { volatile LAS unsigned long long* pr_ = (volatile LAS unsigned long long*)(lds + LDS_PROF); pr_[0] = pr_[0] + ((t1v) - (t0v)); } } while (0)
#else
#define PROF_T(v) do {} while (0)
#define PROF_ACC(id, t0v, t1v) do {} while (0)
#endif

struct EpiProj {
    static constexpr bool PERM = true, AFTER_DRAIN = false;
    bf16_t* O; const float* rinv;
    __device__ __forceinline__ void operator()(const pg8::f32x4 (&acc)[2][2][4][2], const pg8::Unit& u, int wr, int wc, int fr, int fq) const {
        const int row0 = u.pm * 256 + wr * 64 + fr, col0 = u.pn * 256 + wc * 32 + 8 * fq;
        asm volatile("" ::: "memory");
        float rs[2][4];
#pragma unroll
        for (int ai = 0; ai < 2; ++ai)
#pragma unroll
            for (int m = 0; m < 4; ++m) rs[ai][m] = rinv[row0 + ai * 128 + m * 16];
#pragma unroll
        for (int ai = 0; ai < 2; ++ai)
#pragma unroll
            for (int m = 0; m < 4; ++m) {
                const int row = row0 + ai * 128 + m * 16; const float rsv = rs[ai][m];
                bf16_t* rowp = O + (size_t)row * NP + col0;
#pragma unroll
                for (int bj = 0; bj < 2; ++bj) {
                    const pg8::f32x4 v0 = acc[ai][bj][m][0] * rsv, v1 = acc[ai][bj][m][1] * rsv;
                    u32x4 w; w.x = pk2(v0[0], v0[1]); w.y = pk2(v0[2], v0[3]); w.z = pk2(v1[0], v1[1]); w.w = pk2(v1[2], v1[3]);
                    *(u32x4*)(rowp + bj * 128) = w;
                }
            }
    }
};
struct EpiOut0 {
    static constexpr bool PERM = false, AFTER_DRAIN = false;
    bf16_t* xb;
    __device__ __forceinline__ void operator()(const pg8::f32x4 (&acc)[2][2][4][2], const pg8::Unit& u, int wr, int wc, int fr, int fq) const {
        const int row0 = u.pm * 256 + wr * 64 + fr, col0 = u.pn * 256 + wc * 32 + 4 * fq;
#pragma unroll
        for (int ai = 0; ai < 2; ++ai)
#pragma unroll
            for (int m = 0; m < 4; ++m) {
                if (ai == 0 && m == 0) asm volatile("" ::: "memory");
                const size_t off = (size_t)(row0 + ai * 128 + m * 16) * DM + col0;
#pragma unroll
                for (int bj = 0; bj < 2; ++bj)
#pragma unroll
                    for (int n = 0; n < 2; ++n) {
                        const u32x2 xw = *(const u32x2*)(xb + off + bj * 128 + n * 16);
                        pg8::f32x4 v; v[0] = bf_lo(xw.x); v[1] = bf_hi(xw.x); v[2] = bf_lo(xw.y); v[3] = bf_hi(xw.y);
                        v = v + acc[ai][bj][m][n];
                        u32x2 w; w.x = pk2(v[0], v[1]); w.y = pk2(v[2], v[3]); *(u32x2*)(xb + off + bj * 128 + n * 16) = w;
                    }
            }
    }
};
struct EpiOut1 {
    static constexpr bool PERM = false, AFTER_DRAIN = false;
    const bf16_t* xb; float* out;
    __device__ __forceinline__ void operator()(const pg8::f32x4 (&acc)[2][2][4][2], const pg8::Unit& u, int wr, int wc, int fr, int fq) const {
        const int row0 = u.pm * 256 + wr * 64 + fr, col0 = u.pn * 256 + wc * 32 + 4 * fq;
#pragma unroll
        for (int ai = 0; ai < 2; ++ai)
#pragma unroll
            for (int m = 0; m < 4; ++m) {
                if (ai == 0 && m == 0) asm volatile("" ::: "memory");
                const size_t off = (size_t)(row0 + ai * 128 + m * 16) * DM + col0;
#pragma unroll
                for (int bj = 0; bj < 2; ++bj)
#pragma unroll
                    for (int n = 0; n < 2; ++n) {
                        const u32x2 w = *(const u32x2*)(xb + off + bj * 128 + n * 16);
                        pg8::f32x4 v; v[0] = bf_lo(w.x); v[1] = bf_hi(w.x); v[2] = bf_lo(w.y); v[3] = bf_hi(w.y);
                        *(pg8::f32x4*)(out + off + bj * 128 + n * 16) = v + acc[ai][bj][m][n];
                    }
            }
    }
};

__device__ __forceinline__ float win_eff(const Params& p, int l, int k, int n) {
    const float* W = p.w_in + ((size_t)l * DM + k) * INW;
    if (n < 1860) return W[n];
    if (n < C_PU) return (n >= C_GGR && n < C_GGR + 16) ? W[3140 + (n - C_GGR)] : 0.f;
    if (n < C_PZ) {
        const int gi = (n - C_PU) >> 6, d = (n - C_PU) & 63;
        const float* pw = p.pool_w + ((size_t)(l * 4 + gi) * 64) * 64 + d; const float* wr = W + 1860 + gi * 64; float s = 0.f;
        for (int c = 0; c < 64; ++c) s += wr[c] * pw[c * 64];
        return s * p.pool_scale[l * 256 + gi * 64 + d];
    }
    if (n < C_GQ) return W[2116 + (n - C_PZ)];
    if (n < C_GK) return W[2372 + (n - C_GQ)];
    if (n < C_GV) return W[2564 + (n - C_GK)];
    if (n < C_GZ) return W[2756 + (n - C_GV)];
    return W[3156 + (n - C_GZ)];
}

__device__ __forceinline__ void phase_weights(const Params& p, LAS unsigned char* lds, int gw, int ngw, int wave, int lane) {
    LAS float* scr = (LAS float*)(lds + wave * 8704);
    bf16_t* WIN = (bf16_t*)(p.ws + WS_WIN); bf16_t* WOUT = (bf16_t*)(p.ws + WS_WOUT);
    constexpr int NI_IN = 2 * 16 * 112, NI_OUT = 2 * 16 * 32;
    for (int it = gw; it < NI_IN + NI_OUT; it += ngw) {
        const int nn = lane & 31;
        bf16_t* dst; int k0, n0, ldk = DM;
        if (it < NI_IN) {
            const int l = it / 1792, r = it % 1792, kb = r / 112, nb = r % 112; k0 = 64 * kb; n0 = 32 * nb;
            if (n0 >= C_PU && n0 < C_PZ) {
                const int gi = (n0 - C_PU) >> 6, d = ((n0 - C_PU) & 63) + nn;
                const float* pw = p.pool_w + ((size_t)(l * 4 + gi) * 64) * 64 + d; const float scl = p.pool_scale[l * 256 + gi * 64 + d];
                float pwr[64];
#pragma unroll
                for (int c = 0; c < 64; ++c) pwr[c] = pw[c * 64] * scl;
#pragma unroll 2
                for (int i = 0; i < 32; ++i) {
                    const int kk = 2 * i + (lane >> 5), k = k0 + kk;
                    const f32x4* wr = (const f32x4*)(p.w_in + ((size_t)l * DM + k) * INW + 1860 + gi * 64);
                    float sa = 0.f, sb = 0.f;
#pragma unroll
                    for (int c4 = 0; c4 < 16; c4 += 2) { const f32x4 w0 = wr[c4], w1 = wr[c4 + 1];
                        sa += (w0.x * pwr[4 * c4] + w0.y * pwr[4 * c4 + 1]) + (w0.z * pwr[4 * c4 + 2] + w0.w * pwr[4 * c4 + 3]);
                        sb += (w1.x * pwr[4 * c4 + 4] + w1.y * pwr[4 * c4 + 5]) + (w1.z * pwr[4 * c4 + 6] + w1.w * pwr[4 * c4 + 7]); }
                    scr[kk * 33 + nn] = (sa + sb) * p.norm_g[l * DM + k];
                }
            } else {
#pragma unroll 4
                for (int i = 0; i < 32; ++i) { const int kk = 2 * i + (lane >> 5), k = k0 + kk; scr[kk * 33 + nn] = win_eff(p, l, k, n0 + nn) * p.norm_g[l * DM + k]; }
            }
            dst = WIN + (size_t)l * NP * DM;
        } else {
            const int r0 = it - NI_IN, l = r0 / 512, r = r0 % 512, kb = r / 32, nb = r % 32; k0 = 64 * kb; n0 = 32 * nb;
            const float* W = p.w_out + (size_t)l * DM * DM;
#pragma unroll 4
            for (int i = 0; i < 32; ++i) { const int kk = 2 * i + (lane >> 5), k = k0 + kk; scr[kk * 33 + nn] = W[(size_t)k * DM + n0 + nn]; }
            dst = WOUT + (size_t)l * DM * DM;
        }
        LDS_WAIT();
        const int c = lane & 7;
#pragma unroll
        for (int j = 0; j < 4; ++j) {
            const int n = (lane >> 3) + 8 * j; const LAS float* s = scr + (8 * c) * 33 + n;
            u32x4 o; o.x = pk2(s[0 * 33], s[1 * 33]); o.y = pk2(s[2 * 33], s[3 * 33]); o.z = pk2(s[4 * 33], s[5 * 33]); o.w = pk2(s[6 * 33], s[7 * 33]);
            *(u32x4*)(dst + (size_t)(n0 + n) * ldk + k0 + 8 * c) = o;
        }
        LDS_WAIT();
    }
}
__device__ __forceinline__ void phase_prep_x(const Params& p, const float* src, int gw, int ngw, int lane) {
    bf16_t* xb = (bf16_t*)(p.ws + WS_XB); float* rinv = (float*)(p.ws + WS_RINV);
    for (int m0 = gw * 4; m0 < T_TOK; m0 += ngw * 4) {
        f32x4 v[4][4]; float s[4];
#pragma unroll
        for (int r = 0; r < 4; ++r) { const f32x4* xr = (const f32x4*)(src + (size_t)(m0 + r) * DM) + lane;
#pragma unroll
            for (int j = 0; j < 4; ++j) v[r][j] = xr[64 * j]; }
#pragma unroll
        for (int r = 0; r < 4; ++r) { float a = 0.f;
#pragma unroll
            for (int j = 0; j < 4; ++j) a += (v[r][j].x * v[r][j].x + v[r][j].y * v[r][j].y) + (v[r][j].z * v[r][j].z + v[r][j].w * v[r][j].w);
            s[r] = wave_sum(a); }
#pragma unroll
        for (int r = 0; r < 4; ++r) {
            if (lane == 0) rinv[m0 + r] = __builtin_amdgcn_rsqf(s[r] * (1.0f / DM) + 1e-6f);
            u32x2* o8 = (u32x2*)(xb + (size_t)(m0 + r) * DM) + lane;
#pragma unroll
            for (int j = 0; j < 4; ++j) { u32x2 w; w.x = pk2(v[r][j].x, v[r][j].y); w.y = pk2(v[r][j].z, v[r][j].w); o8[64 * j] = w; }
        }
    }
}

__device__ __forceinline__ void phase_rinv_bf16(const Params& p, int gw, int ngw, int lane) {
    const bf16_t* xb = (const bf16_t*)(p.ws + WS_XB); float* rinv = (float*)(p.ws + WS_RINV);
    for (int m0 = gw * 8; m0 < T_TOK; m0 += ngw * 8) {
        u32x4 v[8][2];
#pragma unroll
        for (int r = 0; r < 8; ++r) { const u32x4* xr = (const u32x4*)(xb + (size_t)(m0 + r) * DM) + lane; v[r][0] = xr[0]; v[r][1] = xr[64]; }
#pragma unroll
        for (int r = 0; r < 8; ++r) {
            float f[8], a = 0.f;
            unpack8(v[r][0], f);
#pragma unroll
            for (int k = 0; k < 8; ++k) a += f[k] * f[k];
            unpack8(v[r][1], f);
#pragma unroll
            for (int k = 0; k < 8; ++k) a += f[k] * f[k];
            a = wave_sum(a);
            if (lane == 0) rinv[m0 + r] = __builtin_amdgcn_rsqf(a * (1.0f / DM) + 1e-6f);
        }
    }
}

__device__ __forceinline__ void qknorm_item(const Params& p, int l, int item, int tid, LAS unsigned char* lds) {
    bf16_t* proj = (bf16_t*)(p.ws + WS_PROJ);
    {
        LAS bf16_t* tv = (LAS bf16_t*)lds;
        bf16_t* vT = (bf16_t*)(p.ws + WS_VT);
        const size_t row0 = (size_t)item * 64; const int b = (int)(row0 >> 11), t0 = (int)(row0 & (SEQ - 1));
#pragma unroll
        for (int i = 0; i < 6; ++i) { const int id = tid + 512 * i, r = id / 48, c8 = id % 48; *(LAS u32x4*)(tv + r * 392 + c8 * 8) = *(const u32x4*)(proj + (row0 + r) * NP + C_V + c8 * 8); }
        LDS_BARRIER();
#pragma unroll
        for (int i = 0; i < 6; ++i) {
            const int id = tid + 512 * i, tc = id / 384, hd = id % 384;
            const LAS bf16_t* src = tv + (8 * tc) * 392 + hd;
            u32x4 w; w.x = (unsigned)src[0] | ((unsigned)src[392] << 16); w.y = (unsigned)src[2 * 392] | ((unsigned)src[3 * 392] << 16);
            w.z = (unsigned)src[4 * 392] | ((unsigned)src[5 * 392] << 16); w.w = (unsigned)src[6 * 392] | ((unsigned)src[7 * 392] << 16);
            *(u32x4*)(vT + ((size_t)b * 384 + hd) * SEQ + t0 + 8 * tc) = w;
        }
    }
    {
        u32x4 wv[12];
#pragma unroll
        for (int i = 0; i < 12; ++i) { const int idx = tid + 512 * i, r = idx / 96, ch = idx % 96; wv[i] = *(const u32x4*)(proj + ((size_t)item * 64 + r) * NP + ch * 8); }
#pragma unroll
        for (int i = 0; i < 12; ++i) {
            const int idx = tid + 512 * i, ch = idx % 96;
            float f[8]; unpack8(wv[i], f);
            float ss = 0.f;
#pragma unroll
            for (int k = 0; k < 8; ++k) ss += f[k] * f[k];
            ss += __shfl_xor(ss, 1); ss += __shfl_xor(ss, 2); ss += __shfl_xor(ss, 4);
            const float rn = __builtin_amdgcn_rsqf(ss * (1.0f / 64.0f) + 1e-6f);
            const bool isq = ch < 48; const float* gp = (isq ? p.qg : p.kg) + l * 64 + (ch & 7) * 8; const float sc = isq ? (0.125f * LOG2E) * rn : rn;
#pragma unroll
            for (int k = 0; k < 8; ++k) f[k] = f[k] * sc * gp[k];
            wv[i] = pack8(f);
        }
#pragma unroll
        for (int i = 0; i < 12; ++i) { const int idx = tid + 512 * i, r = idx / 96, ch = idx % 96; *(u32x4*)(proj + ((size_t)item * 64 + r) * NP + ch * 8) = wv[i]; }
    }
}
__device__ __forceinline__ void pool_item(const Params& p, int item, int tid) {
    const bf16_t* proj = (const bf16_t*)(p.ws + WS_PROJ); bf16_t* mix = (bf16_t*)(p.ws + WS_MIX);
    const int ch = tid & 31, rb = tid >> 5; const size_t R0 = (size_t)item * 256 + rb * 16; const int t0r = (int)(R0 & (SEQ - 1));
    const int w = 2 << (ch >> 3);
    const bf16_t* up = proj + R0 * NP + C_PU + ch * 8; const bf16_t* zp = proj + R0 * NP + C_PZ + ch * 8;
    float acc[8], f[8], g[8];
#pragma unroll
    for (int k = 0; k < 8; ++k) acc[k] = 0.f;
    for (int j = 1; j < w; ++j) if (t0r - j >= 0) { unpack8(*(const u32x4*)(up - (size_t)j * NP), f);
#pragma unroll
        for (int k = 0; k < 8; ++k) acc[k] += f[k]; }
    u32x4 outv[16];
#pragma unroll
    for (int i = 0; i < 16; ++i) {
        const int t = t0r + i;
        unpack8(*(const u32x4*)(up + (size_t)i * NP), f);
#pragma unroll
        for (int k = 0; k < 8; ++k) acc[k] += f[k];
        const int cnt = (t + 1 < w) ? (t + 1) : w; const float ic = __builtin_amdgcn_rcpf((float)cnt);
        unpack8(*(const u32x4*)(zp + (size_t)i * NP), g);
#pragma unroll
        for (int k = 0; k < 8; ++k) g[k] = (acc[k] * ic - f[k]) * silu_f(g[k]);
        outv[i] = pack8(g);
        if (t - w + 1 >= 0) { unpack8(*(const u32x4*)(up + ((ptrdiff_t)i - (w - 1)) * NP), f);
#pragma unroll
            for (int k = 0; k < 8; ++k) acc[k] -= f[k]; }
    }
#pragma unroll
    for (int i = 0; i < 16; ++i) *(u32x4*)(mix + (R0 + i) * DM + 384 + ch * 8) = outv[i];
}

__device__ __forceinline__ unsigned f2ord(float f) { const unsigned b = __float_as_uint(f); return b ^ ((b >> 31) ? 0xFFFFFFFFu : 0x80000000u); }
__device__ __forceinline__ void hist_find(const LAS unsigned* hist, int lane, int R, int& B, int& cab, int& nB) {
    const u32x4 a = ((const LAS u32x4*)hist)[2 * lane], b = ((const LAS u32x4*)hist)[2 * lane + 1];
    const unsigned h[8] = {a.x, a.y, a.z, a.w, b.x, b.y, b.z, b.w};
    const unsigned s8 = (h[0] + h[1]) + (h[2] + h[3]) + (h[4] + h[5]) + (h[6] + h[7]);
    unsigned v = s8;
#pragma unroll
    for (int off = 1; off < 64; off <<= 1) { const unsigned tt = (unsigned)__shfl_down((int)v, off); v += (lane + off < 64) ? tt : 0u; }
    const int sx = (int)(v - s8);
    const bool mine = (sx < R) && (R <= (int)v);
    int c = sx, Bk = 0, cabk = 0, nk = 0; bool found = false;
#pragma unroll
    for (int k = 7; k >= 0; --k) { if (!found && c + (int)h[k] >= R) { Bk = 8 * lane + k; cabk = c; nk = (int)h[k]; found = true; } c += (int)h[k]; }
    const u64 mm = __ballot(mine); const int src = mm ? (__ffsll((long long)mm) - 1) : 0;
    B = __builtin_amdgcn_readfirstlane(__shfl(Bk, src)); cab = __builtin_amdgcn_readfirstlane(__shfl(cabk, src)); nB = __builtin_amdgcn_readfirstlane(__shfl(nk, src));
}
template <int NJ>
__device__ __forceinline__ u64 select_row(const LAS float* srow, int t, int lane, LAS unsigned* hist) {
    float f[NJ]; int k18[NJ]; float fmx = -INFINITY, fmn = INFINITY;
#pragma unroll
    for (int j = 0; j < NJ; ++j) {
        const int key = j * 64 + lane; const float v = srow[key]; const bool valid = key <= t;
        f[j] = v; k18[j] = valid ? 0 : -1; fmx = fmaxf(fmx, valid ? v : -INFINITY); fmn = fminf(fmn, valid ? v : INFINITY);
    }
#pragma unroll
    for (int off = 32; off; off >>= 1) { fmx = fmaxf(fmx, __shfl_xor(fmx, off)); fmn = fminf(fmn, __shfl_xor(fmn, off)); }
    const float lo_f = __uint_as_float((unsigned)__builtin_amdgcn_readfirstlane((int)__float_as_uint(fmn)));
    const float hi_f = __uint_as_float((unsigned)__builtin_amdgcn_readfirstlane((int)__float_as_uint(fmx)));
    u64 myword = 0ull; bool fast = false;
    if (hi_f > lo_f) {
        const float sc18 = 262143.0f / (hi_f - lo_f);
        ((LAS u32x4*)hist)[2 * lane] = (u32x4){0u, 0u, 0u, 0u}; ((LAS u32x4*)hist)[2 * lane + 1] = (u32x4){0u, 0u, 0u, 0u};
        LDS_WAIT();
#pragma unroll
        for (int j = 0; j < NJ; ++j) {
            const bool valid = k18[j] >= 0; const unsigned kk = min((unsigned)((f[j] - lo_f) * sc18), 262143u);
            k18[j] = valid ? (int)kk : -1;
            __hip_atomic_fetch_add(hist + (valid ? (kk >> 9) : (unsigned)(512 + lane)), 1u, __ATOMIC_RELAXED, __HIP_MEMORY_SCOPE_WORKGROUP);
        }
        LDS_WAIT();
        int B1, cab1, n1; hist_find(hist, lane, 256, B1, cab1, n1);
        LDS_WAIT();
        ((LAS u32x4*)hist)[2 * lane] = (u32x4){0u, 0u, 0u, 0u}; ((LAS u32x4*)hist)[2 * lane + 1] = (u32x4){0u, 0u, 0u, 0u};
        LDS_WAIT();
#pragma unroll
        for (int j = 0; j < NJ; ++j) __hip_atomic_fetch_add(hist + (((k18[j] >> 9) == B1) ? (unsigned)(k18[j] & 511) : (unsigned)(512 + lane)), 1u, __ATOMIC_RELAXED, __HIP_MEMORY_SCOPE_WORKGROUP);
        LDS_WAIT();
        int B2, cab2, n2; hist_find(hist, lane, 256 - cab1, B2, cab2, n2);
        LDS_WAIT();
        const int kstar = (B1 << 9) | B2, rr = 256 - cab1 - cab2;
        if (rr == n2) {
            fast = true;
#pragma unroll
            for (int j = 0; j < NJ; ++j) { const u64 w = __ballot(k18[j] >= kstar); if (lane == j) myword = w; }
        } else {
            if (n2 > 8) {
                float bmin = INFINITY, bmax = -INFINITY;
#pragma unroll
                for (int j = 0; j < NJ; ++j) { const bool inb = (k18[j] == kstar); bmin = fminf(bmin, inb ? f[j] : INFINITY); bmax = fmaxf(bmax, inb ? f[j] : -INFINITY); }
#pragma unroll
                for (int off = 32; off; off >>= 1) { bmin = fminf(bmin, __shfl_xor(bmin, off)); bmax = fmaxf(bmax, __shfl_xor(bmax, off)); }
                if (__builtin_amdgcn_readfirstlane((int)(bmin == bmax))) {
                    fast = true; int need = rr;
#pragma unroll
                    for (int j = 0; j < NJ; ++j) {
                        u64 w = __ballot(k18[j] > kstar);
                        if (need > 0) {
                            u64 eq = __ballot(k18[j] == kstar); const int c = __popcll(eq);
                            if (c <= need) { w |= eq; need -= c; }
                            else { while (need > 0) { const u64 low = eq & (~eq + 1ull); w |= low; eq ^= low; --need; } }
                        }
                        if (lane == j) myword = w;
                    }
                }
            }
            if (!fast && n2 <= 64) {
                fast = true;
                int base = 0;
#pragma unroll
                for (int j = 0; j < NJ; ++j) {
                    const bool inb = (k18[j] == kstar); const u64 m = __ballot(inb);
                    if (m) {
                        if (inb) { const int pos = base + (int)__builtin_amdgcn_mbcnt_hi((unsigned)(m >> 32), __builtin_amdgcn_mbcnt_lo((unsigned)m, 0u)); hist[pos] = f2ord(f[j]); hist[64 + pos] = (unsigned)(j * 64 + lane); }
                        base += __popcll(m);
                    }
                }
                LDS_WAIT();
                const unsigned cu = (lane < n2) ? hist[lane] : 0u; const int ck = (lane < n2) ? (int)hist[64 + lane] : 0;
                LDS_WAIT();
                int rank = 0;
                for (int k = 0; k < n2; ++k) { const unsigned x = (unsigned)__builtin_amdgcn_readlane((int)cu, k); rank += (x > cu || (x == cu && k < lane)) ? 1 : 0; }
                const u64 selm = __ballot((lane < n2) && (rank < rr));
#pragma unroll
                for (int j = 0; j < NJ; ++j) { const u64 w = __ballot(k18[j] > kstar); if (lane == j) myword = w; }
                for (int k = 0; k < n2; ++k) if ((selm >> k) & 1ull) { const int key = __builtin_amdgcn_readlane(ck, k); if (lane == (key >> 6)) myword |= 1ull << (key & 63); }
            }
        }
    }
    if (!fast) {
        PROF_T(fb0);
#ifdef PROBE_SEC
        LAS unsigned char* lds = (LAS unsigned char*)hist - LDS_HIST;
#endif
        unsigned u[NJ]; unsigned umax = 0u;
#pragma unroll
        for (int j = 0; j < NJ; ++j) { u[j] = (k18[j] >= 0) ? f2ord(f[j]) : 0u; umax = max(umax, u[j]); }
#pragma unroll
        for (int off = 32; off; off >>= 1) umax = max(umax, (unsigned)__shfl_xor((int)umax, off));
        const unsigned hi_u = (unsigned)__builtin_amdgcn_readfirstlane((int)umax);
        unsigned prefix = 0u; int cge = t + 1;
        for (int bit = 31; bit >= 0; --bit) {
            const unsigned cand = prefix | (1u << bit);
            if (cand > hi_u) continue;
            int cnt = 0;
#pragma unroll
            for (int j = 0; j < NJ; ++j) cnt += __popcll(__ballot(u[j] >= cand));
            if (cnt >= 256) { prefix = cand; cge = cnt; }
            if (cnt == 256) break;
        }
        int cgt = 0;
#pragma unroll
        for (int j = 0; j < NJ; ++j) cgt += __popcll(__ballot(u[j] > prefix));
        int need = 256 - cgt;
#pragma unroll
        for (int j = 0; j < NJ; ++j) {
            u64 w = __ballot(u[j] > prefix); u64 eq = __ballot(u[j] == prefix); const int c = __popcll(eq);
            if (c <= need) { w |= eq; need -= c; }
            else { while (need > 0) { const u64 low = eq & (~eq + 1ull); w |= low; eq ^= low; --need; } }
            if (lane == j) myword = w;
        }
        PROF_T(fb1); PROF_ACC(11, fb0, fb1);
    }
    return myword;
}
__device__ __forceinline__ void causal_item(const Params& p, int b, int tid) {
    u64* mask = (u64*)(p.ws + WS_MASK);
#pragma unroll 4
    for (int idx = tid; idx < 256 * 32; idx += 512) {
        const int t = idx >> 5, j = idx & 31, lo = j * 64; u64 w;
        if (t >= lo + 63) w = ~0ull; else if (t < lo) w = 0ull; else w = (2ull << (t - lo)) - 1ull;
        mask[((size_t)b * SEQ + t) * 32 + j] = w;
    }
}
__device__ __forceinline__ bool sel_item(const Params& p, int b, int qt, LAS unsigned char* lds, int tid, int wave, int lane, unsigned* ctr) {
    u64* mask = (u64*)(p.ws + WS_MASK);
    const int t0 = qt * 16;
    if (t0 < 256) {
        const int n = tid >> 5, j = tid & 31, t = t0 + n, lo = j * 64; u64 w;
        if (t >= lo + 63) w = ~0ull; else if (t < lo) w = 0ull; else w = (2ull << (t - lo)) - 1ull;
        mask[((size_t)b * SEQ + t) * 32 + j] = w;
        return false;
    }
    PROF_T(st0);
    const bf16_t* pb = (const bf16_t*)(p.ws + WS_PROJ) + (size_t)b * SEQ * NP;
    LAS float* sc = (LAS float*)lds;
    const int n = lane & 15, g = lane >> 4;
    {
        bf16x8 bq[4][2]; float iw[4];
        const bf16_t* qrow = pb + (size_t)(t0 + n) * NP;
#pragma unroll
        for (int h = 0; h < 4; ++h) {
#pragma unroll
            for (int ks = 0; ks < 2; ++ks) bq[h][ks] = as_bf8(*(const u32x4*)(qrow + C_IQ + h * 64 + ks * 32 + g * 8));
        }
        { const u32x2 w = *(const u32x2*)(qrow + C_IW); iw[0] = 0.5f * bf_lo(w.x); iw[1] = 0.5f * bf_hi(w.x); iw[2] = 0.5f * bf_lo(w.y); iw[3] = 0.5f * bf_hi(w.y); }
        const int nkt = qt + 1;
        for (int kt = wave; kt < nkt; kt += 8) {
            const bf16_t* krow = pb + (size_t)(kt * 16 + n) * NP + C_IK + g * 8;
            const bf16x8 a0 = as_bf8(*(const u32x4*)krow), a1 = as_bf8(*(const u32x4*)(krow + 32));
            f32x4 s = {0.f, 0.f, 0.f, 0.f};
#pragma unroll
            for (int h = 0; h < 4; ++h) {
                f32x4 c = {0.f, 0.f, 0.f, 0.f};
                c = mfma16(a0, bq[h][0], c); c = mfma16(a1, bq[h][1], c);
#pragma unroll
                for (int r = 0; r < 4; ++r) s[r] += iw[h] * fmaxf(c[r], 0.f);
            }
            *(LAS f32x4*)(sc + n * 2052 + kt * 16 + 4 * g) = s;
        }
    }
    PROF_T(st1); PROF_ACC(5, st0, st1);
    LDS_BARRIER();
    PROF_T(st2); PROF_ACC(6, st1, st2);
    unsigned nxt = 0u;
    if (tid == 448) nxt = atomicAdd(ctr, 1u);
#pragma unroll 1
    for (int qi = 0; qi < 2; ++qi) {
        const int nq = wave + 8 * qi, t = t0 + nq, nw = (t >> 6) + 1; const LAS float* srow = sc + nq * 2052;
        u64 w;
        LAS unsigned* hist = (LAS unsigned*)(lds + LDS_HIST + wave * 2304);
        if (nw <= 8) w = select_row<8>(srow, t, lane, hist);
        else if (nw <= 16) w = select_row<16>(srow, t, lane, hist);
        else if (nw <= 24) w = select_row<24>(srow, t, lane, hist);
        else w = select_row<32>(srow, t, lane, hist);
        if (lane < 32) mask[((size_t)b * SEQ + t) * 32 + lane] = w;
    }
    if (tid == 448) ((volatile LAS unsigned*)(lds + LDS_QUEUE))[0] = nxt;
    PROF_T(st3); PROF_ACC(7, st2, st3);
    return true;
}

__device__ __forceinline__ void gla_seq(const Params& p, int l, int b, int h, LAS unsigned char* lds, int tid, int wave, int lane) {
    LAS bf16_t* bq = (LAS bf16_t*)(lds);
    LAS bf16_t* bk = (LAS bf16_t*)(lds + 9216);
    LAS bf16_t* bkdT = (LAS bf16_t*)(lds + 18432);
    LAS bf16_t* bvT = (LAS bf16_t*)(lds + 25344);
    LAS bf16_t* bST = (LAS bf16_t*)(lds + 39168);
    LAS float* fb = (LAS float*)(lds + 52992);
    LAS float* fs = (LAS float*)(lds + 65280);
    LAS float* fo = (LAS float*)(lds + 66816);
    for (int i = tid; i < 13248; i += 512) ((LAS unsigned*)lds)[i] = 0u;
    __syncthreads();
    const bf16_t* proj = (const bf16_t*)(p.ws + WS_PROJ); bf16_t* mix = (bf16_t*)(p.ws + WS_MIX);
    const size_t rowbase = (size_t)b * SEQ;
    const int n = lane & 15, g = lane >> 4, t_e = tid >> 3, dc = tid & 7;
    f32x4 st[3];
#pragma unroll
    for (int k = 0; k < 3; ++k) st[k] = (f32x4){0.f, 0.f, 0.f, 0.f};
    const int gtt = wave & 3, jt0 = (wave < 4) ? 0 : 2, njt = (wave < 4) ? 2 : 1;
    bf16x8 wgB[2]; float gbias[2];
#pragma unroll
    for (int q = 0; q < 2; ++q) {
        float wv[8];
#pragma unroll
        for (int i = 0; i < 8; ++i) wv[i] = (g < 2 && q < njt) ? p.wgate[((size_t)l * 16 + 8 * g + i) * 192 + h * 48 + 16 * (jt0 + q) + n] : 0.f;
        wgB[q] = as_bf8(pack8(wv)); gbias[q] = (q < njt) ? p.bgate[l * 192 + h * 48 + 16 * (jt0 + q) + n] : 0.f;
    }
    u32x4 rz = {0, 0, 0, 0}, rq = {0, 0, 0, 0}, rk = {0, 0, 0, 0}, rv0 = {0, 0, 0, 0}, rv1 = {0, 0, 0, 0};
    u32x2 rg[3] = {{0, 0}, {0, 0}, {0, 0}}, rgn[3] = {{0, 0}, {0, 0}, {0, 0}};
    float gain12[12];
#pragma unroll
    for (int i = 0; i < 12; ++i) gain12[i] = p.ogain[l * 96 + dc * 12 + i];
    const int v0t = tid / 12, v0e = tid % 12, v1t = (tid + 512) / 12, v1e = (tid + 512) % 12;
#define GLA_LOAD(cc) do { const size_t R_ = rowbase + 64 * (size_t)(cc); const bf16_t* rp_ = proj + (R_ + t_e) * NP; \
        if (dc < 6) { rq = *(const u32x4*)(rp_ + C_GQ + h * 48 + dc * 8); rk = *(const u32x4*)(rp_ + C_GK + h * 48 + dc * 8); } \
        rz = (g < 2) ? *(const u32x4*)(proj + (R_ + 16 * gtt + n) * NP + C_GGR + 8 * g) : (u32x4){0u, 0u, 0u, 0u}; \
        rv0 = *(const u32x4*)(proj + (R_ + v0t) * NP + C_GV + h * 96 + v0e * 8); \
        if (tid < 256) rv1 = *(const u32x4*)(proj + (R_ + v1t) * NP + C_GV + h * 96 + v1e * 8); \
        rgn[0] = *(const u32x2*)(rp_ + C_GZ + h * 96 + dc * 12); rgn[1] = *(const u32x2*)(rp_ + C_GZ + h * 96 + dc * 12 + 4); rgn[2] = *(const u32x2*)(rp_ + C_GZ + h * 96 + dc * 12 + 8); } while (0)
    GLA_LOAD(0);
#pragma unroll 1
    for (int c = 0; c < 32; ++c) {
        const size_t R0 = rowbase + 64 * (size_t)c;
        rg[0] = rgn[0]; rg[1] = rgn[1]; rg[2] = rgn[2];
#pragma unroll
        for (int q = 0; q < 2; ++q) {
            if (q < njt) {
                f32x4 zc = {0.f, 0.f, 0.f, 0.f};
                zc = mfma16(as_bf8(rz), wgB[q], zc);
#pragma unroll
                for (int r = 0; r < 4; ++r) { const float x = zc[r] + gbias[q]; const float ls = fminf(x, 0.f) - __logf(1.0f + __expf(-fabsf(x))); fb[(16 * gtt + 4 * g + r) * 48 + 16 * (jt0 + q) + n] = ls * 0.0625f; }
            }
        }
        LDS_BARRIER();
        float pre[8]; const int seg = tid / 48, d = tid - seg * 48;
        if (tid < 384) { float run = 0.f;
#pragma unroll
            for (int i = 0; i < 8; ++i) { run += fb[(8 * seg + i) * 48 + d]; pre[i] = run; }
            fs[seg * 48 + d] = run; }
        LDS_BARRIER();
        if (tid < 384) { float off = 0.f;
#pragma unroll
            for (int s = 0; s < 8; ++s) off += (s < seg) ? fs[s * 48 + d] : 0.f;
#pragma unroll
            for (int i = 0; i < 8; ++i) fb[(8 * seg + i) * 48 + d] = pre[i] + off; }
        LDS_BARRIER();
        if (dc < 6) {
            float q[8], k[8], qt[8], kt[8]; unpack8(rq, q); unpack8(rk, k);
#pragma unroll
            for (int i = 0; i < 8; ++i) {
                const float bb = fb[t_e * 48 + dc * 8 + i], bl = fb[63 * 48 + dc * 8 + i];
                qt[i] = q[i] * __expf(bb) * 0.14433756729740643f; kt[i] = k[i] * __expf(-bb);
                const float kd = k[i] * __expf(bl - bb);
                bkdT[(dc * 8 + i) * 72 + t_e] = (bf16_t)(pk2(kd, 0.f) & 0xffffu);
            }
            *(LAS u32x4*)(bq + t_e * 72 + dc * 8) = pack8(qt); *(LAS u32x4*)(bk + t_e * 72 + dc * 8) = pack8(kt);
        }
        {
            const unsigned wv[4] = {rv0.x, rv0.y, rv0.z, rv0.w};
#pragma unroll
            for (int i = 0; i < 4; ++i) { bvT[(v0e * 8 + 2 * i) * 72 + v0t] = (bf16_t)(wv[i] & 0xffffu); bvT[(v0e * 8 + 2 * i + 1) * 72 + v0t] = (bf16_t)(wv[i] >> 16); }
            if (tid < 256) { const unsigned wu[4] = {rv1.x, rv1.y, rv1.z, rv1.w};
#pragma unroll
                for (int i = 0; i < 4; ++i) { bvT[(v1e * 8 + 2 * i) * 72 + v1t] = (bf16_t)(wu[i] & 0xffffu); bvT[(v1e * 8 + 2 * i + 1) * 72 + v1t] = (bf16_t)(wu[i] >> 16); } }
        }
        LDS_BARRIER();
        if (c + 1 < 32) GLA_LOAD(c + 1);
        {
            const int it = wave & 3, eh = wave >> 2;
            bf16x8 qB[2];
#pragma unroll
            for (int ks = 0; ks < 2; ++ks) qB[ks] = as_bf8(*(const LAS u32x4*)(bq + (16 * it + n) * 72 + 32 * ks + 8 * g));
            f32x4 at[4];
#pragma unroll
            for (int jt = 0; jt < 4; ++jt) {
                f32x4 cc = {0.f, 0.f, 0.f, 0.f};
                if (jt <= it) {
                    const bf16x8 a0 = as_bf8(*(const LAS u32x4*)(bk + (16 * jt + n) * 72 + 8 * g)), a1 = as_bf8(*(const LAS u32x4*)(bk + (16 * jt + n) * 72 + 32 + 8 * g));
                    cc = mfma16(a0, qB[0], cc); cc = mfma16(a1, qB[1], cc);
                    if (jt == it) {
#pragma unroll
                        for (int r = 0; r < 4; ++r) if (4 * g + r > n) cc[r] = 0.f;
                    }
                }
                at[jt] = cc;
            }
            bf16x8 pf[2];
#pragma unroll
            for (int s2 = 0; s2 < 2; ++s2) { u32x4 w; w.x = pk2(at[2 * s2][0], at[2 * s2][1]); w.y = pk2(at[2 * s2][2], at[2 * s2][3]); w.z = pk2(at[2 * s2 + 1][0], at[2 * s2 + 1][1]); w.w = pk2(at[2 * s2 + 1][2], at[2 * s2 + 1][3]); pf[s2] = as_bf8(w); }
#pragma unroll
            for (int ei = 0; ei < 3; ++ei) {
                const int et = 3 * eh + ei; f32x4 oa = {0.f, 0.f, 0.f, 0.f};
#pragma unroll
                for (int s2 = 0; s2 < 2; ++s2) {
                    const u32x2 lo = *(const LAS u32x2*)(bvT + (16 * et + n) * 72 + 32 * s2 + 4 * g), hi = *(const LAS u32x2*)(bvT + (16 * et + n) * 72 + 32 * s2 + 16 + 4 * g);
                    u32x4 w; w.x = lo.x; w.y = lo.y; w.z = hi.x; w.w = hi.y;
                    oa = mfma16(as_bf8(w), pf[s2], oa);
                }
#pragma unroll
                for (int ks = 0; ks < 2; ++ks) oa = mfma16(as_bf8(*(const LAS u32x4*)(bST + (16 * et + n) * 72 + 32 * ks + 8 * g)), qB[ks], oa);
                *(LAS f32x4*)(fo + (16 * it + n) * 100 + 16 * et + 4 * g) = oa;
            }
#pragma unroll
            for (int kk = 0; kk < 3; ++kk) {
                const int tile = wave + 8 * kk;
                if (tile < 18) {
                    const int et = tile / 3, dtl = tile % 3; const float dec = __expf(fb[63 * 48 + 16 * dtl + n]);
                    f32x4 acc = st[kk] * dec;
#pragma unroll
                    for (int ks = 0; ks < 2; ++ks) acc = mfma16(as_bf8(*(const LAS u32x4*)(bvT + (16 * et + n) * 72 + 32 * ks + 8 * g)), as_bf8(*(const LAS u32x4*)(bkdT + (16 * dtl + n) * 72 + 32 * ks + 8 * g)), acc);
                    st[kk] = acc;
                }
            }
        }
        LDS_BARRIER();
#pragma unroll
        for (int kk = 0; kk < 3; ++kk) {
            const int tile = wave + 8 * kk;
            if (tile < 18) { const int et = tile / 3, dtl = tile % 3;
#pragma unroll
                for (int r = 0; r < 4; ++r) bST[(16 * et + 4 * g + r) * 72 + 16 * dtl + n] = (bf16_t)(pk2(st[kk][r], 0.f) & 0xffffu); }
        }
        {
            const int e0 = dc * 12; float v[12];
#pragma unroll
            for (int j = 0; j < 3; ++j) { const f32x4 x = *(const LAS f32x4*)(fo + t_e * 100 + e0 + 4 * j); v[4 * j] = x[0]; v[4 * j + 1] = x[1]; v[4 * j + 2] = x[2]; v[4 * j + 3] = x[3]; }
            float ss = 0.f;
#pragma unroll
            for (int i = 0; i < 12; ++i) ss += v[i] * v[i];
            ss += __shfl_xor(ss, 1); ss += __shfl_xor(ss, 2); ss += __shfl_xor(ss, 4);
            const float rin = __builtin_amdgcn_rsqf(ss * (1.0f / 96.0f) + 1e-6f);
            bf16_t* op = mix + (R0 + t_e) * DM + 640 + h * 96 + e0;
#pragma unroll
            for (int j = 0; j < 3; ++j) {
                const u32x2 zw = rg[j];
                const float o0 = v[4 * j] * rin * gain12[4 * j] * silu_f(bf_lo(zw.x)), o1 = v[4 * j + 1] * rin * gain12[4 * j + 1] * silu_f(bf_hi(zw.x));
                const float o2 = v[4 * j + 2] * rin * gain12[4 * j + 2] * silu_f(bf_lo(zw.y)), o3 = v[4 * j + 3] * rin * gain12[4 * j + 3] * silu_f(bf_hi(zw.y));
                u32x2 w; w.x = pk2(o0, o1); w.y = pk2(o2, o3); *(u32x2*)(op + 4 * j) = w;
            }
        }
    }
#undef GLA_LOAD
    __syncthreads();
}

__device__ __forceinline__ void att_qk(const LAS bf16_t* Kb, const bf16x8 (&qf)[2][2], f32x4 (&s)[2][4], int n, int g) {
#pragma unroll
    for (int ks = 0; ks < 4; ++ks) {
        const bf16x8 a0 = as_bf8(*(const LAS u32x4*)(Kb + (16 * ks + n) * 72 + 8 * g)), a1 = as_bf8(*(const LAS u32x4*)(Kb + (16 * ks + n) * 72 + 32 + 8 * g));
#pragma unroll
        for (int qi = 0; qi < 2; ++qi) { f32x4 c = {0.f, 0.f, 0.f, 0.f}; c = mfma16(a0, qf[qi][0], c); c = mfma16(a1, qf[qi][1], c); s[qi][ks] = c; }
    }
}
__device__ __forceinline__ void att_softmax_pv(const LAS bf16_t* Vt, const LAS u64* mkrow0, int kt, f32x4 (&s)[2][4], f32x4 (&o)[2][4], float (&lsum)[2], int n, int g) {
    bf16x8 pf[2][2];
#pragma unroll
    for (int qi = 0; qi < 2; ++qi) {
        const u64 mw = mkrow0[qi * 16 * 33 + kt];
        const unsigned mlo = (unsigned)(mw >> (4 * g)), mhi = (unsigned)(mw >> (32 + 4 * g));
        float ps = 0.f;
#pragma unroll
        for (int ks = 0; ks < 4; ++ks)
#pragma unroll
            for (int r = 0; r < 4; ++r) {
                const unsigned word = (ks < 2) ? mlo : mhi; const int idx = 16 * (ks & 1) + r;
                const int mm = ((int)(word << (31 - idx))) >> 31;
                const float pv = __uint_as_float(__float_as_uint(__builtin_amdgcn_exp2f(s[qi][ks][r])) & (unsigned)mm);
                s[qi][ks][r] = pv; ps += pv;
            }
        lsum[qi] += ps;
#pragma unroll
        for (int s2 = 0; s2 < 2; ++s2) { u32x4 w; w.x = pk2(s[qi][2 * s2][0], s[qi][2 * s2][1]); w.y = pk2(s[qi][2 * s2][2], s[qi][2 * s2][3]); w.z = pk2(s[qi][2 * s2 + 1][0], s[qi][2 * s2 + 1][1]); w.w = pk2(s[qi][2 * s2 + 1][2], s[qi][2 * s2 + 1][3]); pf[qi][s2] = as_bf8(w); }
    }
#pragma unroll
    for (int dt = 0; dt < 4; ++dt)
#pragma unroll
        for (int s2 = 0; s2 < 2; ++s2) {
            const u32x2 lo = *(const LAS u32x2*)(Vt + (16 * dt + n) * 72 + 32 * s2 + 4 * g), hi = *(const LAS u32x2*)(Vt + (16 * dt + n) * 72 + 32 * s2 + 16 + 4 * g);
            u32x4 w; w.x = lo.x; w.y = lo.y; w.z = hi.x; w.w = hi.y;
#pragma unroll
            for (int qi = 0; qi < 2; ++qi) o[qi][dt] = mfma16(as_bf8(w), pf[qi][s2], o[qi][dt]);
        }
}
__device__ __forceinline__ void attn_unit(const Params& p, int b, int qb, int h0, LAS unsigned char* lds, int tid, int wave, int lane) {
    LAS u64* mk = (LAS u64*)lds;
    LAS bf16_t* KB = (LAS bf16_t*)(lds + 67584);
    LAS bf16_t* VT = (LAS bf16_t*)(lds + 67584 + 36864);
    const bf16_t* vTg = (const bf16_t*)(p.ws + WS_VT);
    const bf16_t* proj = (const bf16_t*)(p.ws + WS_PROJ); bf16_t* mix = (bf16_t*)(p.ws + WS_MIX); const u64* mask = (const u64*)(p.ws + WS_MASK);
    const int t0 = qb * 256, nt = 4 * qb + 4;
    const size_t rowb = (size_t)b * SEQ;
    __syncthreads();
#pragma unroll 4
    for (int idx = tid; idx < 256 * 32; idx += 512) { const int q = idx >> 5, w = idx & 31; if (w < nt) mk[q * 33 + w] = mask[(rowb + t0 + q) * 32 + w]; }
    __syncthreads();
    const int n = lane & 15, g = lane >> 4;
    const size_t qrow = rowb + t0 + 32 * wave + n;
    const LAS u64* mkrow0 = mk + (32 * wave + n) * 33;
    const int skey = tid >> 3, sc8 = tid & 7;
#pragma unroll 1
    for (int hh = 0; hh < 3; ++hh) {
        const int h = h0 + hh;
        bf16x8 qf[2][2];
#pragma unroll
        for (int qi = 0; qi < 2; ++qi)
#pragma unroll
            for (int ks = 0; ks < 2; ++ks) qf[qi][ks] = as_bf8(*(const u32x4*)(proj + (qrow + 16 * qi) * NP + C_Q + h * 64 + ks * 32 + g * 8));
        f32x4 o[2][4];
#pragma unroll
        for (int qi = 0; qi < 2; ++qi)
#pragma unroll
            for (int dt = 0; dt < 4; ++dt) o[qi][dt] = (f32x4){0.f, 0.f, 0.f, 0.f};
        float lsum[2] = {0.f, 0.f};
        const bf16_t* kp = proj + (rowb + skey) * NP + C_K + h * 64 + sc8 * 8;
        const bf16_t* vp = vTg + ((size_t)(b * 6 + h) * 64 + skey) * SEQ + sc8 * 8;
        const int np = nt >> 1;
        u32x4 rk[2], rv[2];
#pragma unroll
        for (int tt = 0; tt < 2; ++tt) { rk[tt] = *(const u32x4*)(kp + (size_t)tt * 64 * NP); rv[tt] = *(const u32x4*)(vp + tt * 64); }
#define ATT_STAGE(pb) do { _Pragma("unroll") for (int tt_ = 0; tt_ < 2; ++tt_) { *(LAS u32x4*)(KB + ((pb) * 2 + tt_) * 4608 + skey * 72 + sc8 * 8) = rk[tt_]; \
            *(LAS u32x4*)(VT + ((pb) * 2 + tt_) * 4608 + skey * 72 + sc8 * 8) = rv[tt_]; } } while (0)
        ATT_STAGE(0);
        __syncthreads();
#pragma unroll 1
        for (int pp = 0; pp < np; ++pp) {
            if (pp + 1 < np) {
#pragma unroll
                for (int tt = 0; tt < 2; ++tt) { rk[tt] = *(const u32x4*)(kp + (size_t)(2 * pp + 2 + tt) * 64 * NP); rv[tt] = *(const u32x4*)(vp + (2 * pp + 2 + tt) * 64); }
            }
            const LAS bf16_t* Kb = KB + (pp & 1) * 9216; const LAS bf16_t* Vt = VT + (pp & 1) * 9216;
            f32x4 sA[2][4];
            att_qk(Kb, qf, sA, n, g);
            att_softmax_pv(Vt, mkrow0, 2 * pp, sA, o, lsum, n, g);
            att_qk(Kb + 4608, qf, sA, n, g);
            att_softmax_pv(Vt + 4608, mkrow0, 2 * pp + 1, sA, o, lsum, n, g);
            if (pp + 1 < np) ATT_STAGE((pp + 1) & 1);
            LDS_BARRIER();
        }
#undef ATT_STAGE
#pragma unroll
        for (int qi = 0; qi < 2; ++qi) {
            float lt = lsum[qi]; lt += __shfl_xor(lt, 16); lt += __shfl_xor(lt, 32);
            const float inv = __builtin_amdgcn_rcpf(lt);
            const bf16_t* azp = proj + (qrow + 16 * qi) * NP + C_AZ + h * 64 + 4 * g; bf16_t* op = mix + (qrow + 16 * qi) * DM + h * 64 + 4 * g;
#pragma unroll
            for (int dt = 0; dt < 4; ++dt) {
                const u32x2 zw = *(const u32x2*)(azp + 16 * dt);
                const float o0 = o[qi][dt][0] * inv * silu_f(bf_lo(zw.x)), o1 = o[qi][dt][1] * inv * silu_f(bf_hi(zw.x)), o2 = o[qi][dt][2] * inv * silu_f(bf_lo(zw.y)), o3 = o[qi][dt][3] * inv * silu_f(bf_hi(zw.y));
                u32x2 w; w.x = pk2(o0, o1); w.y = pk2(o2, o3); *(u32x2*)(op + 16 * dt) = w;
            }
        }
    }
}

#define XB_TMO      128
#define XB_XCNT(j)  (256  + 64 * (j))
#define XB_XSUB(j)  (1280 + 64 * (j))
#define XB_XGEN(j)  (2304 + 64 * (j))
#define XB_TOP      3328
#define XB_TOPGEN   3392
#define XCD_BAR_WORDS 3456
#define XB_SPIN_CAP (1u << 18)

__device__ __forceinline__ unsigned xb_ld(unsigned* p)              { return __hip_atomic_load(p, __ATOMIC_RELAXED, __HIP_MEMORY_SCOPE_AGENT); }
__device__ __forceinline__ unsigned xb_add(unsigned* p, unsigned v) { return __hip_atomic_fetch_add(p, v, __ATOMIC_RELAXED, __HIP_MEMORY_SCOPE_AGENT); }
__device__ __forceinline__ unsigned xb_xcc_id() { return (unsigned)__builtin_amdgcn_s_getreg((3 << 11) | 20) & 0xFu; }
#define XB_SPIN(cond, bar) do { unsigned _sp = 0; while (cond) { __builtin_amdgcn_s_sleep(1); \
    if ((++_sp & 255u) == 0u) { if (xb_ld(&(bar)[XB_TMO])) break; if (_sp > XB_SPIN_CAP) { atomicAdd(&(bar)[XB_TMO], 1u); break; } } } } while (0)

struct XcdBarrier {
    unsigned* bar; unsigned x;
    volatile LAS unsigned* st;
};

__device__ __forceinline__ XcdBarrier xcd_barrier_post(unsigned* bar, volatile LAS unsigned* st) {
    XcdBarrier b; b.bar = bar; b.x = xb_xcc_id(); b.st = st;
    if (threadIdx.x == 0) (void)xb_add(&bar[XB_XCNT(b.x)], 1u);
    return b;
}
__device__ __forceinline__ void xcd_barrier_complete(unsigned* bar, unsigned x, unsigned& nloc, unsigned& nx) {
    const unsigned G = gridDim.x * gridDim.y * gridDim.z;
    unsigned sum, cnt, mine, sp = 0u;
    for (;;) {
        sum = 0u; cnt = 0u; mine = 0u;
#pragma unroll
        for (unsigned j = 0; j < 16; ++j) { const unsigned c = xb_ld(&bar[XB_XCNT(j)]); sum += c; cnt += (c > 0u) ? 1u : 0u; mine = (j == x) ? c : mine; }
        if (sum == G) break;
        __builtin_amdgcn_s_sleep(1);
        if ((++sp & 255u) == 0u) { if (xb_ld(&bar[XB_TMO])) break; if (sp > XB_SPIN_CAP) { atomicAdd(&bar[XB_TMO], 1u); break; } }
    }
    nloc = mine > 0u ? mine : 1u; nx = cnt > 0u ? cnt : 1u;
}

__device__ __forceinline__ void xcd_barrier(const XcdBarrier& b) {
    asm volatile("s_waitcnt vmcnt(0)" ::: "memory");
    __syncthreads();
    if (threadIdx.x == 0) {
        unsigned* bar = b.bar;
        __builtin_amdgcn_s_waitcnt(0);
        unsigned nloc = b.st[0], nx = b.st[1];
        if (nloc == 0u) { xcd_barrier_complete(bar, b.x, nloc, nx); b.st[0] = nloc; b.st[1] = nx; }
        const unsigned old = xb_add(&bar[XB_XSUB(b.x)], 1u);
        const unsigned gen = old / nloc;
        if (old + 1u == (gen + 1u) * nloc) {
            __builtin_amdgcn_fence(__ATOMIC_RELEASE, "agent");
            asm volatile("s_waitcnt vmcnt(0)" ::: "memory");
            const unsigned og = xb_add(&bar[XB_TOP], 1u);
            const unsigned tg = og / nx;
            if (og + 1u == (tg + 1u) * nx) xb_add(&bar[XB_TOPGEN], 1u);
            else XB_SPIN(xb_ld(&bar[XB_TOPGEN]) == tg, bar);
            __builtin_amdgcn_fence(__ATOMIC_ACQUIRE, "agent");
            xb_add(&bar[XB_XGEN(b.x)], 1u);
            asm volatile("s_waitcnt vmcnt(0)" ::: "memory");
        } else {
            XB_SPIN(xb_ld(&bar[XB_XGEN(b.x)]) == gen, bar);
            __builtin_amdgcn_fence(__ATOMIC_ACQUIRE, "agent");
            asm volatile("s_waitcnt vmcnt(0)" ::: "memory");
        }
    }
    __syncthreads();
}


__global__ void __launch_bounds__(512, 2) mega_fwd(Params pin) {
    extern __shared__ __attribute__((aligned(16))) unsigned char lds_raw[];
    LAS unsigned char* lds = (LAS unsigned char*)lds_raw;
    cg::grid_group grid = cg::this_grid();
#ifdef PROBE_SEC
    if (threadIdx.x == 0) ((volatile LAS unsigned long long*)(lds + LDS_PROF))[0] = 0ull;
#endif
    XcdBarrier xbar; xbar.bar = nullptr; xbar.x = 0; xbar.st = nullptr;
    if (!MULTI_LAUNCH) {
        volatile LAS unsigned* st = (volatile LAS unsigned*)(lds + LDS_XBST);
        if (threadIdx.x == 0) { st[0] = 0u; st[1] = 0u; }
        __syncthreads();
        xbar = xcd_barrier_post((unsigned*)(pin.ws + WS_CTL) + CW_BAR, st);
    }
#pragma unroll 1
    for (int ph = pin.lo; ph < pin.hi; ++ph) {
#ifdef PROBE_SUB
        const int nrep = ((ph > 0 && (ph - 1) % 5 == PROBE_SUB) || (ph == 0 && PROBE_SUB == 5)) ? 2 : 1;
#else
        const int nrep = 1;
#endif
#pragma unroll 1
        for (int rep = 0; rep < nrep; ++rep) {
        int tid = threadIdx.x; asm volatile("" : "+v"(tid));
        Params p = pin; { size_t z_ = 0; asm volatile("" : "+s"(z_)); p.ws = pin.ws + z_; }
        const int lane = tid & 63, wave = __builtin_amdgcn_readfirstlane(tid >> 6);
        const int G = gridDim.x, bid = blockIdx.x;
        const int gw = bid * 8 + wave, ngw = G * 8;
        bf16_t* XB = (bf16_t*)(p.ws + WS_XB); bf16_t* PROJ = (bf16_t*)(p.ws + WS_PROJ); bf16_t* MIX = (bf16_t*)(p.ws + WS_MIX); float* RINV = (float*)(p.ws + WS_RINV);
        if (rep) __syncthreads();
        if (ph == 0) {
            phase_weights(p, lds, gw, ngw, wave, lane);
            phase_prep_x(p, p.x, gw, ngw, lane);
        } else {
            const int l = (ph - 1) / 5, sub = (ph - 1) % 5;
            if (sub == 0) {
                pg8::Gemm gm{XB, (const bf16_t*)(p.ws + WS_WIN) + (size_t)l * NP * DM, T_TOK, NP, DM};
                pg8::StaticOrder S; S.init(T_TOK, NP, G, bid);
                EpiProj E{PROJ, RINV};
                pg8::gemm_phase<EpiProj, pg8::StaticOrder>(lds, gm, S, E, nullptr);
            } else if (sub == 1) {
                { PROF_T(gt0); for (int gi = bid; gi < 128; gi += G) gla_seq(p, l, gi >> 2, gi & 3, lds, tid, wave, lane); PROF_T(gt1); PROF_ACC(9, gt0, gt1); }
#ifdef PROBE_GLA
                for (int gi = bid; gi < 128; gi += G) gla_seq(p, l, gi >> 2, gi & 3, lds, tid, wave, lane);
#endif
#ifdef PROBE_SEL
                { unsigned* ctr2 = (unsigned*)(p.ws + WS_CTL) + 64 * l + 32; volatile LAS unsigned* qw2 = (volatile LAS unsigned*)(lds + LDS_QUEUE);
                  for (;;) { __syncthreads(); if (tid == 0) qw2[0] = atomicAdd(ctr2, 1u); __syncthreads(); const int item = (int)qw2[0]; if (item >= 4096) break; (void)sel_item(p, item & 31, 127 - (item >> 5), lds, tid, wave, lane, ctr2 + 8); } }
#endif
                unsigned* ctr = (unsigned*)(p.ws + WS_CTL) + 64 * l + 16 * rep;
                volatile LAS unsigned* qw = (volatile LAS unsigned*)(lds + LDS_QUEUE);
                bool have = false;
                for (;;) {
                    int tq = tid; asm volatile("" : "+v"(tq));
                    const int lq = tq & 63, wq = __builtin_amdgcn_readfirstlane(tq >> 6);
                    LDS_BARRIER();
                    if (!have) { if (tq == 0) qw[0] = atomicAdd(ctr, 1u); LDS_BARRIER(); }
                    const int item = (int)qw[0];
                    have = false;
                    if (item >= 3584 + 32 + 1024 + 256) break;
                    if (item < 3584) have = sel_item(p, item & 31, 127 - (item >> 5), lds, tq, wq, lq, ctr);
                    else if (item < 3616) causal_item(p, item - 3584, tq);
                    else if (item < 4640) { if (rep == nrep - 1) qknorm_item(p, l, item - 3616, tq, lds); }
                    else pool_item(p, item - 4640, tq);
                }
            } else if (sub == 2) {
                for (int pj = bid; pj < 256; pj += G) {
                    const int pi = (G == 256) ? ((pj & 7) * 32 + (pj >> 3)) : pj;
                    const int b = pi >> 3, pp = (pi >> 1) & 3, h0 = 3 * (pi & 1);
                    attn_unit(p, b, 7 - pp, h0, lds, tid, wave, lane);
                    attn_unit(p, b, pp, h0, lds, tid, wave, lane);
                }
            } else if (sub == 3) {
                pg8::Gemm gm{MIX, (const bf16_t*)(p.ws + WS_WOUT) + (size_t)l * DM * DM, T_TOK, DM, DM};
                pg8::StaticOrder S; S.init(T_TOK, DM, G, bid);
                if (l == 0) { EpiOut0 E{XB}; pg8::gemm_phase<EpiOut0, pg8::StaticOrder>(lds, gm, S, E, nullptr); }
                else { EpiOut1 E{XB, rep == nrep - 1 ? p.out : (float*)PROJ}; pg8::gemm_phase<EpiOut1, pg8::StaticOrder>(lds, gm, S, E, nullptr); }
            } else {
                if (l == 0) phase_rinv_bf16(p, gw, ngw, lane);
            }
        }
        }
        if (ph + 1 < pin.hi) { if (MULTI_LAUNCH || pin.lo > pin.hi) grid.sync(); else xcd_barrier(xbar); }
    }
#ifdef PROBE_SEC
    if (blockIdx.x == PROBE_BLK && threadIdx.x == 0) {
        const unsigned long long acc = ((volatile LAS unsigned long long*)(lds + LDS_PROF))[0], s0 = clock64();
        while ((unsigned long long)clock64() - s0 < acc) __builtin_amdgcn_s_sleep(8);
    }
#endif
}

extern "C" void kernel_launch(void* const* d_in, const int* in_sizes, int n_in, void* d_out, int out_size, void* d_ws, size_t ws_size, hipStream_t stream) {
    static int grid_blocks = 0;
    if (!grid_blocks) {
        if (n_in != 11 || ws_size < WS_END) { fprintf(stderr, "kernel_launch: unexpected inputs (n_in %d, ws %zu)\n", n_in, ws_size); return; }
        if (hipFuncSetAttribute((const void*)mega_fwd, hipFuncAttributeMaxDynamicSharedMemorySize, LDS_BYTES) != hipSuccess) { fprintf(stderr, "kernel_launch: hipFuncSetAttribute failed\n"); return; }
        int dev = 0, cus = 0, per_cu = 0;
        (void)hipGetDevice(&dev); (void)hipDeviceGetAttribute(&cus, hipDeviceAttributeMultiprocessorCount, dev);
        (void)hipOccupancyMaxActiveBlocksPerMultiprocessor(&per_cu, mega_fwd, 512, LDS_BYTES);
        if (per_cu < 1) { fprintf(stderr, "kernel_launch: occupancy query says 0 blocks per CU\n"); return; }
        grid_blocks = cus * per_cu; if (grid_blocks > 256) grid_blocks = 256;
    }
    Params p{};
    p.x = (const float*)d_in[0]; p.norm_g = (const float*)d_in[1]; p.w_in = (const float*)d_in[2]; p.qg = (const float*)d_in[3]; p.kg = (const float*)d_in[4];
    p.pool_w = (const float*)d_in[5]; p.pool_scale = (const float*)d_in[6]; p.wgate = (const float*)d_in[7]; p.bgate = (const float*)d_in[8]; p.ogain = (const float*)d_in[9];
    p.w_out = (const float*)d_in[10]; p.out = (float*)d_out; p.ws = (unsigned char*)d_ws;
    (void)hipMemsetAsync((char*)d_ws + WS_CTL, 0, CTL_BYTES, stream);
#if MULTI_LAUNCH
    for (int ph = 0; ph < N_PHASES; ++ph) { p.lo = ph; p.hi = ph + 1; hipLaunchKernelGGL(mega_fwd, dim3(grid_blocks), dim3(512), LDS_BYTES, stream, p); }
#else
    p.lo = 0; p.hi = N_PHASES;
    void* args[] = {&p};
    hipError_t e = hipLaunchCooperativeKernel((const void*)mega_fwd, dim3(grid_blocks), dim3(512), args, LDS_BYTES, stream);
    if (e != hipSuccess) fprintf(stderr, "cooperative launch failed: %s (grid %d)\n", hipGetErrorString(e), grid_blocks);
#endif
}
```
